# Optimizing an MI355X kernel written in HIP

```python
import math
import jax, jax.numpy as jnp
from jax import lax
import numpy as np

D_MODEL = 1024
BATCH = 32
SEQ = 2048
DEPTH = 1

N_META = 16
MIX_WIDTH = D_MODEL
ATTN_WIDTH = MIX_WIDTH // 2
POOL_WIDTH = MIX_WIDTH - ATTN_WIDTH
ATTN_HEAD_DIM = 64
ATTN_HEADS = ATTN_WIDTH // (2 * ATTN_HEAD_DIM)
ATTN_VALUE_DIM = 2 * ATTN_HEAD_DIM
POOL_WINDOWS = (2, 4, 8, 16)
POOL_GROUPS = len(POOL_WINDOWS)
POOL_GROUP_DIM = POOL_WIDTH // POOL_GROUPS
IN_WIDTH = 3 * ATTN_WIDTH + POOL_WIDTH
N_EXPERTS = 16
EXPERT_CAPACITY_FACTOR = 2
D_FF = 2048
ROPE_THETA = 10000.0
Q_BLOCK = 128
EPS = 1e-6

kernel_name = "hymba_diffattn_pool_ecmoe_block"


def _rms(x, g):
    x32 = x.astype(jnp.float32)
    y = x32 * lax.rsqrt(jnp.mean(x32 * x32, axis=-1, keepdims=True) + EPS)
    return (y * g.astype(jnp.float32)).astype(x.dtype)


def _rope(x, pos):
    half = x.shape[-1] // 2
    freqs = ROPE_THETA ** (-jnp.arange(half, dtype=jnp.float32) / half)
    ang = pos[:, None] * freqs[None, :]
    cos = jnp.cos(ang).astype(x.dtype)
    sin = jnp.sin(ang).astype(x.dtype)
    x1, x2 = x[..., :half], x[..., half:]
    return jnp.concatenate([x1 * cos - x2 * sin, x1 * sin + x2 * cos], axis=-1)


def _diff_attention(q, k, v, lam, lam_init, subln_g):
    B, L = q.shape[0], q.shape[1]
    H, dh, dv = ATTN_HEADS, ATTN_HEAD_DIM, ATTN_VALUE_DIM
    pos = jnp.arange(L, dtype=jnp.float32)
    q = _rope(jnp.transpose(q, (0, 2, 3, 1, 4)), pos)
    k = _rope(jnp.transpose(k, (0, 2, 3, 1, 4)), pos)
    v = jnp.transpose(v, (0, 2, 1, 3))
    n_blk = -(-L // Q_BLOCK)
    Lp = n_blk * Q_BLOCK
    q = jnp.pad(q, ((0, 0), (0, 0), (0, 0), (0, Lp - L), (0, 0)))
    qb = jnp.moveaxis(q.reshape(B, H, 2, n_blk, Q_BLOCK, dh), 3, 0)
    scale = dh ** -0.5

    def one_block(qblk):
        s = jnp.einsum('bhmqd,bhmkd->bhmqk', qblk, k).astype(jnp.float32) * scale
        p = jax.nn.softmax(s, axis=-1)
        a = p[:, :, 0] - lam * p[:, :, 1]
        return jnp.einsum('bhqk,bhkd->bhqd', a.astype(v.dtype), v)

    o = lax.map(one_block, qb)
    o = jnp.moveaxis(o, 0, 2).reshape(B, H, Lp, dv)[:, :, :L]
    o = _rms(o, subln_g) * (1.0 - lam_init)
    return jnp.transpose(o, (0, 2, 1, 3)).reshape(B, L, H * dv)


def _pool_mixer(p, pool_w, pool_scale):
    B, L, _ = p.shape
    p32 = p.astype(jnp.float32)
    cs = jnp.concatenate([jnp.zeros((B, 1, POOL_WIDTH), jnp.float32), jnp.cumsum(p32, axis=1)], axis=1)
    t = jnp.arange(L)
    outs = []
    for g, w in enumerate(POOL_WINDOWS):
        lo = jnp.clip(t - w // 2, 0, L)
        hi = jnp.clip(t + w // 2, 0, L)
        c0, c1 = g * POOL_GROUP_DIM, (g + 1) * POOL_GROUP_DIM
        csg = cs[:, :, c0:c1]
        mean = (csg[:, hi] - csg[:, lo]) / (hi - lo).astype(jnp.float32)[None, :, None]
        outs.append(mean - p32[:, :, c0:c1])
    d = jnp.stack(outs, axis=2).astype(p.dtype)
    y = jnp.einsum('blgc,gcd->blgd', d, pool_w)
    return y.reshape(B, L, POOL_WIDTH) * pool_scale


def _expert_choice_ffn(h, w_router, w_gate, w_up, w_down):
    B, L, D = h.shape
    cap = EXPERT_CAPACITY_FACTOR * L // N_EXPERTS
    aff = jax.nn.softmax(jnp.einsum('bld,de->ble', h, w_router).astype(jnp.float32), axis=-1)
    gates, idx = lax.top_k(jnp.swapaxes(aff, 1, 2), cap)
    xg = jax.vmap(lambda hb, ib: hb[ib])(h, idx)
    a = jax.nn.silu(jnp.einsum('becd,edf->becf', xg, w_gate)) * jnp.einsum('becd,edf->becf', xg, w_up)
    y = jnp.einsum('becf,efd->becd', a, w_down) * gates[..., None].astype(h.dtype)
    return jax.vmap(lambda ib, yb: jnp.zeros((L, D), yb.dtype).at[ib.reshape(-1)].add(yb.reshape(-1, D)))(idx, y)


def setup_inputs(seed: int = 0) -> dict:
    key = jax.random.key(seed)
    ks = jax.random.split(key, 20)
    f32 = jnp.float32
    nrm = lambda k, shape, s: jax.random.normal(k, shape, f32) * s
    gain = lambda k, shape: 1.0 + 0.01 * jax.random.normal(k, shape, f32)
    return {
        "x": nrm(ks[0], (BATCH, SEQ, D_MODEL), 1.0),
        "meta_tokens": nrm(ks[1], (N_META, D_MODEL), 1.0),
        "ln1_g": gain(ks[2], (DEPTH, D_MODEL)),
        "w_in": nrm(ks[3], (DEPTH, D_MODEL, IN_WIDTH), D_MODEL ** -0.5),
        "q_norm_g": gain(ks[4], (DEPTH, ATTN_HEAD_DIM)),
        "k_norm_g": gain(ks[5], (DEPTH, ATTN_HEAD_DIM)),
        "lambda_q1": nrm(ks[6], (DEPTH, ATTN_HEAD_DIM), 0.1),
        "lambda_k1": nrm(ks[7], (DEPTH, ATTN_HEAD_DIM), 0.1),
        "lambda_q2": nrm(ks[8], (DEPTH, ATTN_HEAD_DIM), 0.1),
        "lambda_k2": nrm(ks[9], (DEPTH, ATTN_HEAD_DIM), 0.1),
        "subln_g": gain(ks[10], (DEPTH, ATTN_VALUE_DIM)),
        "pool_w": nrm(ks[11], (DEPTH, POOL_GROUPS, POOL_GROUP_DIM, POOL_GROUP_DIM), POOL_GROUP_DIM ** -0.5),
        "pool_scale": gain(ks[12], (DEPTH, POOL_WIDTH)),
        "w_out": nrm(ks[13], (DEPTH, MIX_WIDTH, D_MODEL), MIX_WIDTH ** -0.5),
        "ln2_g": gain(ks[14], (DEPTH, D_MODEL)),
        "w_router": nrm(ks[15], (DEPTH, D_MODEL, N_EXPERTS), D_MODEL ** -0.5),
        "w_gate": nrm(ks[16], (DEPTH, N_EXPERTS, D_MODEL, D_FF), D_MODEL ** -0.5),
        "w_up": nrm(ks[17], (DEPTH, N_EXPERTS, D_MODEL, D_FF), D_MODEL ** -0.5),
        "w_down": nrm(ks[18], (DEPTH, N_EXPERTS, D_FF, D_MODEL), D_FF ** -0.5),
    }


def reference(x, meta_tokens, ln1_g, w_in, q_norm_g, k_norm_g, lambda_q1, lambda_k1, lambda_q2, lambda_k2,
              subln_g, pool_w, pool_scale, w_out, ln2_g, w_router, w_gate, w_up, w_down):
    B = x.shape[0]
    meta = jnp.broadcast_to(meta_tokens[None].astype(x.dtype), (B, N_META, D_MODEL))
    h = jnp.concatenate([meta, x], axis=1)
    L = h.shape[1]
    for l in range(DEPTH):
        lam_init = 0.8 - 0.6 * math.exp(-0.3 * l)
        hn = _rms(h, ln1_g[l])
        proj = jnp.einsum('bld,dn->bln', hn, w_in[l])
        q = proj[..., :ATTN_WIDTH].reshape(B, L, ATTN_HEADS, 2, ATTN_HEAD_DIM)
        k = proj[..., ATTN_WIDTH:2 * ATTN_WIDTH].reshape(B, L, ATTN_HEADS, 2, ATTN_HEAD_DIM)
        v = proj[..., 2 * ATTN_WIDTH:3 * ATTN_WIDTH].reshape(B, L, ATTN_HEADS, ATTN_VALUE_DIM)
        p = proj[..., 3 * ATTN_WIDTH:]
        q = _rms(q, q_norm_g[l])
        k = _rms(k, k_norm_g[l])
        lam = (jnp.exp(jnp.sum(lambda_q1[l].astype(jnp.float32) * lambda_k1[l].astype(jnp.float32)))
               - jnp.exp(jnp.sum(lambda_q2[l].astype(jnp.float32) * lambda_k2[l].astype(jnp.float32)))
               + lam_init)
        attn = _diff_attention(q, k, v, lam, lam_init, subln_g[l])
        pool = _pool_mixer(p, pool_w[l], pool_scale[l])
        mix = jnp.concatenate([attn, pool], axis=-1)
        h = h + jnp.einsum('blm,md->bld', mix, w_out[l])
        h = h + _expert_choice_ffn(_rms(h, ln2_g[l]), w_router[l], w_gate[l], w_up[l], w_down[l])
    return h[:, N_META:]
```

```cpp
#include <hip/hip_runtime.h>
#include <cstdio>
#include <cstdint>

#ifndef MK_N_LAUNCHES
#define MK_N_LAUNCHES 1
#endif

constexpr int BATCH = 32, SEQ = 2048, NMETA = 16, L = SEQ + NMETA  , LP = 2112  , D = 1024;
constexpr int M = BATCH * L;
constexpr int NIN = 2048, AW = 512, NH = 4, DH = 64, DV = 128;
constexpr int NE = 16, CAP = 258, ER = BATCH * CAP  , EP = 8448  , FF = 2048, MT = NE * EP;
constexpr float EPS = 1e-6f;
constexpr float QSCALE = 0.125f * 1.4426950408889634f;
constexpr float LAM_INIT = 0.2f;

#define GAS __attribute__((address_space(1)))
#define LAS __attribute__((address_space(3)))
typedef unsigned short bf16;
typedef unsigned v4u __attribute__((ext_vector_type(4)));
typedef float f32x4 __attribute__((ext_vector_type(4)));
typedef float f32x2 __attribute__((ext_vector_type(2)));
typedef float f32x16 __attribute__((ext_vector_type(16)));
typedef short bf16x8 __attribute__((ext_vector_type(8)));
typedef short s16x4 __attribute__((ext_vector_type(4)));
typedef __bf16 bf16x2_t __attribute__((ext_vector_type(2)));
typedef GAS unsigned gu32;
#define RLX_AGENT __ATOMIC_RELAXED, __HIP_MEMORY_SCOPE_AGENT
#define LDS_WAIT() asm volatile("s_waitcnt lgkmcnt(0)" ::: "memory")
#define VM_WAIT() asm volatile("s_waitcnt vmcnt(0)" ::: "memory")
__device__ __forceinline__ unsigned pk2(float lo, float hi) { f32x2 v = {lo, hi}; bf16x2_t b = __builtin_convertvector(v, bf16x2_t); return __builtin_bit_cast(unsigned, b); }
__device__ __forceinline__ unsigned pk4_fp8(float a, float b, float c, float d) { int w = __builtin_amdgcn_cvt_pk_fp8_f32(a, b, 0, false); w = __builtin_amdgcn_cvt_pk_fp8_f32(c, d, w, true); return (unsigned)w; }
constexpr float W8SCALE = 64.0f, W8INV = 1.0f / 64.0f;
__device__ __forceinline__ float bf_lo(unsigned w) { return __uint_as_float(w << 16); }
__device__ __forceinline__ float bf_hi(unsigned w) { return __uint_as_float(w & 0xffff0000u); }
template <int CTRL> __device__ __forceinline__ float dpp_mov(float v) { return __uint_as_float((unsigned)__builtin_amdgcn_update_dpp(0, (int)__float_as_uint(v), CTRL, 0xF, 0xF, true)); }
__device__ __forceinline__ float row16_sum(float v) { v += dpp_mov<0xB1>(v); v += dpp_mov<0x4E>(v); v += dpp_mov<0x141>(v); v += dpp_mov<0x140>(v); return v; }
__device__ __forceinline__ float row16_max(float v) { v = fmaxf(v, dpp_mov<0xB1>(v)); v = fmaxf(v, dpp_mov<0x4E>(v)); v = fmaxf(v, dpp_mov<0x141>(v)); v = fmaxf(v, dpp_mov<0x140>(v)); return v; }
__device__ __forceinline__ float swap16_sum(float v) { const auto r = __builtin_amdgcn_permlane16_swap(__float_as_uint(v), __float_as_uint(v), false, false); return __uint_as_float(r[0]) + __uint_as_float(r[1]); }
__device__ __forceinline__ float swap32_sum(float v) { const auto r = __builtin_amdgcn_permlane32_swap(__float_as_uint(v), __float_as_uint(v), false, false); return __uint_as_float(r[0]) + __uint_as_float(r[1]); }
__device__ __forceinline__ float wave_sum(float v) { return swap32_sum(swap16_sum(row16_sum(v))); }
template <int CTRL> __device__ __forceinline__ unsigned dpp_shr0(unsigned v) { return (unsigned)__builtin_amdgcn_update_dpp(0, (int)v, CTRL, 0xF, 0xF, true); }
__device__ __forceinline__ unsigned wave_scan_incl(unsigned v, int lane) {
    v += dpp_shr0<0x111>(v); v += dpp_shr0<0x112>(v); v += dpp_shr0<0x114>(v); v += dpp_shr0<0x118>(v);
    const unsigned t0 = (unsigned)__builtin_amdgcn_readlane((int)v, 15), t1 = (unsigned)__builtin_amdgcn_readlane((int)v, 31), t2 = (unsigned)__builtin_amdgcn_readlane((int)v, 47);
    const int row = lane >> 4;
    return v + (row >= 1 ? t0 : 0u) + (row >= 2 ? t1 : 0u) + (row >= 3 ? t2 : 0u);
}

namespace pg8 {
typedef unsigned short bf16_t;
typedef unsigned u32x4 __attribute__((ext_vector_type(4)));
typedef unsigned u32x2 __attribute__((ext_vector_type(2)));
typedef int v4i_t __attribute__((ext_vector_type(4)));
typedef int v8i_t __attribute__((ext_vector_type(8)));
constexpr int BM = 256, BK = 64, HALF = 128, HTB = HALF * BK * 2, STAGE_BYTES = 8 * HTB, NXCD = 8, WGM = 8;
__host__ __device__ __forceinline__ int lds_byte(int r, int c16) { return (r >> 3) * 1024 + (r & 7) * 128 + ((c16 ^ (r & 6)) << 4); }
__host__ __device__ __forceinline__ void stage_rc(int b, int& R, int& C) { const int p = b >> 10, j = (b & 1023) >> 4, rr = j >> 3; R = 8 * p + rr; C = ((j & 7) ^ (rr & 6)) * 8; }
__host__ __device__ __forceinline__ int perm32(int rho) { const int n = rho >> 4, i = rho & 15; return 8 * (i >> 2) + 4 * n + (i & 3); }

struct Unit { int pm, pn, pb; };
struct Gemm { const bf16_t* A; const bf16_t* Bt; int K; const int* rows; };

struct StaticOrder {
    int nM, nN, nwg, G, c, grp;
    __device__ void init(int nM_, int nN_, int G_, int c_, int grp_) { nM = nM_; nN = nN_; nwg = nM * nN; G = G_; c = c_; grp = grp_; }
    __device__ bool next(int i, Unit& u) const {
        const long Lx = (long)i * G + c; if (Lx >= nwg) return false;
        int wgid = (int)Lx; { const int q = nwg / NXCD, r = nwg % NXCD, xcd = wgid % NXCD, off = wgid / NXCD; wgid = (xcd < r ? xcd * (q + 1) : r * (q + 1) + (xcd - r) * q) + off; }
        const int nig = WGM * nN, gid = wgid / nig, fm = gid * WGM, gsz = (nM - fm) < WGM ? (nM - fm) : WGM;
        u.pm = fm + ((wgid % nig) % gsz); u.pn = (wgid % nig) / gsz; u.pb = grp ? (u.pm / grp) * nN + u.pn : u.pn; return true;
    }
};

template <class Epi, bool GATHER, int FP8 = 0, bool PROBE_SAME = false, bool NTA = false>
__device__ __forceinline__ void gemm_phase(LAS unsigned char* lds, const Gemm g, const StaticOrder& S, const Epi& E) {
    const int tid = threadIdx.x, wid = __builtin_amdgcn_readfirstlane(tid >> 6), lane = tid & 63, wr = wid >> 2, wc = wid & 3, fr = lane & 15, fq = lane >> 4;
    const int K = g.K, nt = K / BK;
    unsigned voffA[2], voffB[2]; int stR[2], stC[2];
#pragma unroll
    for (int i = 0; i < 2; ++i) { int R, C; stage_rc(tid * 16 + i * 8192, R, C); const int Rb = Epi::PERM ? ((R & ~31) + perm32(R & 31)) : R;
        stR[i] = R; stC[i] = C; voffA[i] = (unsigned)(R * K + C) * 2u; voffB[i] = (unsigned)(Rb * K + C) * 2u; }
    const size_t kstep = (size_t)(BK * 2);
    const size_t hstep = (size_t)HALF * K * 2;
    const size_t tstep = 2 * hstep;
    const unsigned ldsw = (unsigned)wid * 1024u;
    const int aoff0 = lds_byte(wr * 64 + fr, fq), aoff1 = lds_byte(wr * 64 + fr, 4 + fq), boff0 = lds_byte(wc * 32 + fr, fq), boff1 = lds_byte(wc * 32 + fr, 4 + fq);
#define PG8_SA(b, h) (((b) * 2 + (h)) * HTB)
#define PG8_SB(b, h) ((4 + (b) * 2 + (h)) * HTB)
#define PG8_STAGE_X(bufoff, gbase, voff, AUX) do { const char* _gb = (const char*)(gbase); asm volatile("" : "+s"(_gb)); _Pragma("unroll") for (int _i = 0; _i < 2; ++_i) { \
        unsigned _vo = (voff)[_i]; asm volatile("" : "+v"(_vo));     \
        __builtin_amdgcn_global_load_lds((const unsigned*)(_gb + _vo), (LAS unsigned*)(lds + (bufoff) + ldsw + _i * 8192), 16, 0, AUX); } } while (0)
#define PG8_STAGE(bufoff, gbase, voff) PG8_STAGE_X(bufoff, gbase, voff, 0)
#define PG8_STAGE_A(b, h, kp, VO) do { if constexpr (GATHER) { PG8_STAGE(PG8_SA(b, h), (kp), VO[h]); } else if constexpr (NTA) { PG8_STAGE_X(PG8_SA(b, h), (kp) + (h) * hstep, voffA, 2); } else { PG8_STAGE(PG8_SA(b, h), (kp) + (h) * hstep, voffA); } } while (0)
#define PG8_LDA(dst, b, h) do { _Pragma("unroll") for (int m = 0; m < 4; ++m) { const v4i_t lo_ = *(const LAS v4i_t*)(lds + PG8_SA(b, h) + aoff0 + m * 2048), hi_ = *(const LAS v4i_t*)(lds + PG8_SA(b, h) + aoff1 + m * 2048); \
        dst[m] = __builtin_shufflevector(lo_, hi_, 0, 1, 2, 3, 4, 5, 6, 7); } } while (0)
#define PG8_LDB(dst, b, h) do { _Pragma("unroll") for (int n = 0; n < 2; ++n) { const v4i_t lo_ = *(const LAS v4i_t*)(lds + PG8_SB(b, h) + boff0 + n * 2048), hi_ = *(const LAS v4i_t*)(lds + PG8_SB(b, h) + boff1 + n * 2048); \
        dst[n] = __builtin_shufflevector(lo_, hi_, 0, 1, 2, 3, 4, 5, 6, 7); } } while (0)
#define PG8_LO(x) __builtin_bit_cast(bf16x8, __builtin_shufflevector(x, x, 0, 1, 2, 3))
#define PG8_HI(x) __builtin_bit_cast(bf16x8, __builtin_shufflevector(x, x, 4, 5, 6, 7))
#define PG8_MMA(ai, bj, At, Bt, Z) do { __builtin_amdgcn_s_setprio(1); if constexpr (FP8 == 3) { _Pragma("unroll") for (int m = 0; m < 4; ++m) asm volatile("" :: "v"(At[m])); \
        _Pragma("unroll") for (int n = 0; n < 2; ++n) asm volatile("" :: "v"(Bt[n])); \
        if (Z) { _Pragma("unroll") for (int m = 0; m < 4; ++m) _Pragma("unroll") for (int n = 0; n < 2; ++n) acc[ai][bj][m][n] = (f32x4){0.f, 0.f, 0.f, 0.f}; } \
        } else if constexpr (FP8) { _Pragma("unroll") for (int m = 0; m < 4; ++m) _Pragma("unroll") for (int n = 0; n < 2; ++n) \
        { if constexpr (FP8 == 2) { if (Z) acc[ai][bj][m][n] = (f32x4){0.f, 0.f, 0.f, 0.f}; \
            asm volatile("v_mfma_f32_16x16x128_f8f6f4 %0, %1, %2, %0 cbsz:2 blgp:2" : "+v"(acc[ai][bj][m][n]) : "v"(__builtin_shufflevector(Bt[n], Bt[n], 0, 1, 2, 3, 4, 5)), "v"(__builtin_shufflevector(At[m], At[m], 0, 1, 2, 3, 4, 5))); } \
          else if (Z) asm volatile("v_mfma_f32_16x16x128_f8f6f4 %0, %1, %2, 0" : "=&v"(acc[ai][bj][m][n]) : "v"(Bt[n]), "v"(At[m])); \
          else asm volatile("v_mfma_f32_16x16x128_f8f6f4 %0, %1, %2, %0" : "+v"(acc[ai][bj][m][n]) : "v"(Bt[n]), "v"(At[m])); } } else { \
        _Pragma("unroll") for (int m = 0; m < 4; ++m) _Pragma("unroll") for (int n = 0; n < 2; ++n) { \
        if (Z) acc[ai][bj][m][n] = (f32x4){0.f, 0.f, 0.f, 0.f};     \
        acc[ai][bj][m][n] = __builtin_amdgcn_mfma_f32_16x16x32_bf16(PG8_LO(Bt[n]), PG8_LO(At[m]), acc[ai][bj][m][n], 0, 0, 0); \
        acc[ai][bj][m][n] = __builtin_amdgcn_mfma_f32_16x16x32_bf16(PG8_HI(Bt[n]), PG8_HI(At[m]), acc[ai][bj][m][n], 0, 0, 0); } } __builtin_amdgcn_s_setprio(0); } while (0)
#define PG8_WAIT_V(n) asm volatile("s_waitcnt vmcnt(" #n ")" ::: "memory")
#define PG8_WAIT_L(n) asm volatile("s_waitcnt lgkmcnt(" #n ")" ::: "memory")
#define PG8_BAR __builtin_amdgcn_s_barrier()
#define PG8_SCHED __builtin_amdgcn_sched_barrier(0)
#define PG8_LOADVO(dst, un) do { _Pragma("unroll") for (int _h = 0; _h < 2; ++_h) _Pragma("unroll") for (int _i = 0; _i < 2; ++_i) { \
        const int _gr = PROBE_SAME ? stR[_i] : g.rows[(un).pm * BM + _h * HALF + stR[_i]]; dst[_h][_i] = (unsigned)(_gr * K + stC[_i]) * 2u; } } while (0)
#define PG8_LOADRAW(dst, un) do { _Pragma("unroll") for (int _h = 0; _h < 2; ++_h) _Pragma("unroll") for (int _i = 0; _i < 2; ++_i) { \
        const int* _rp = g.rows + ((un).pm * BM + _h * HALF + stR[_i]); asm volatile("global_load_dword %0, %1, off" : "=&v"(dst[_h][_i]) : "v"(_rp) : "memory"); } } while (0)
#define PG8_KITER(Z) { \
            const bool last = (t == nt - 2); \
            const char* a1 = cA + (size_t)(t + 1) * kstep; \
            const char* a2 = last ? nA : cA + (size_t)(t + 2) * kstep; const char* b2 = last ? nB : cB + (size_t)(t + 2) * kstep; \
            const char* a3 = a2 + kstep; const char* b3 = b2 + kstep; \
            unsigned v2[2][2]; \
            _Pragma("unroll") for (int h = 0; h < 2; ++h) { v2[h][0] = last ? vnxt[h][0] : vcur[h][0]; v2[h][1] = last ? vnxt[h][1] : vcur[h][1]; } \
              \
            PG8_LDB(B0, 0, 0); PG8_LDB(B1, 0, 1); PG8_SCHED; PG8_LDA(At, 0, 0); PG8_STAGE_A(1, 1, a1, vcur); \
            PG8_WAIT_V(8); PG8_WAIT_L(0); PG8_BAR; PG8_MMA(0, 0, At, B0, Z); PG8_MMA(0, 1, At, B1, Z); PG8_BAR; PG8_SCHED; \
              \
            PG8_LDA(At, 0, 1); PG8_STAGE(PG8_SB(0, 0), b2, voffB); PG8_STAGE(PG8_SB(0, 1), b2 + hstep, voffB); PG8_STAGE_A(0, 0, a2, v2); \
            PG8_WAIT_V(8); PG8_WAIT_L(0); PG8_BAR; PG8_MMA(1, 0, At, B0, Z); PG8_MMA(1, 1, At, B1, Z); PG8_BAR; PG8_SCHED; \
              \
            PG8_LDB(B0, 1, 0); PG8_LDB(B1, 1, 1); PG8_SCHED; PG8_LDA(At, 1, 0); PG8_STAGE_A(0, 1, a2, v2); \
            PG8_WAIT_V(8); PG8_WAIT_L(0); PG8_BAR; PG8_MMA(0, 0, At, B0, 0); PG8_MMA(0, 1, At, B1, 0); PG8_BAR; PG8_SCHED; \
              \
            PG8_LDA(At, 1, 1); PG8_STAGE(PG8_SB(1, 0), b3, voffB); PG8_STAGE(PG8_SB(1, 1), b3 + hstep, voffB); PG8_STAGE_A(1, 0, a3, v2); \
            PG8_WAIT_V(8); PG8_WAIT_L(0); PG8_BAR; PG8_MMA(1, 0, At, B0, 0); PG8_MMA(1, 1, At, B1, 0); PG8_BAR; PG8_SCHED; }
    Unit cur, nxt, nn; int ui = 0;
    if (!S.next(0, cur)) return;
    bool has_next = S.next(1, nxt);
    f32x4 acc[2][2][4][2];
    v8i_t At[4], B0[2], B1[2];
    unsigned vcur[2][2] = {{0u, 0u}, {0u, 0u}}, vnxt[2][2] = {{0u, 0u}, {0u, 0u}};
    if constexpr (GATHER) { PG8_LOADVO(vcur, cur); if (has_next) { PG8_LOADVO(vnxt, nxt); } else {
#pragma unroll
        for (int h = 0; h < 2; ++h) { vnxt[h][0] = vcur[h][0]; vnxt[h][1] = vcur[h][1]; } }
        PG8_WAIT_V(0); }
    const char* cA = (const char*)g.A + (GATHER ? (size_t)0 : (size_t)cur.pm * tstep); const char* cB = (const char*)g.Bt + (PROBE_SAME ? (size_t)0 : (size_t)cur.pb * tstep);
    PG8_STAGE(PG8_SB(0, 0), cB, voffB); PG8_STAGE(PG8_SB(0, 1), cB + hstep, voffB); PG8_STAGE_A(0, 0, cA, vcur); PG8_STAGE_A(0, 1, cA, vcur);
    if (wr == 1) PG8_BAR;
    PG8_WAIT_V(2); PG8_BAR;
    PG8_STAGE(PG8_SB(1, 0), cB + kstep, voffB); PG8_STAGE_A(1, 0, cA + kstep, vcur); PG8_STAGE(PG8_SB(1, 1), cB + hstep + kstep, voffB);
    PG8_WAIT_V(6); PG8_BAR;
    for (;;) {
        const char* nA = has_next ? (const char*)g.A + (GATHER ? (size_t)0 : (size_t)nxt.pm * tstep) : cA; const char* nB = has_next ? (const char*)g.Bt + (PROBE_SAME ? (size_t)0 : (size_t)nxt.pb * tstep) : cB;
        if constexpr (FP8 == 1) {
            { const int t = 0; PG8_KITER(1) }
            for (int t = 2; t < nt; t += 2) PG8_KITER(0)
        } else {
#pragma unroll
            for (int a = 0; a < 2; ++a)
#pragma unroll
                for (int b = 0; b < 2; ++b)
#pragma unroll
                    for (int m = 0; m < 4; ++m)
#pragma unroll
                        for (int n = 0; n < 2; ++n) acc[a][b][m][n] = (f32x4){0.f, 0.f, 0.f, 0.f};
            for (int t = 0; t < nt; t += 2) PG8_KITER(0)
        }
        const bool has_nn = has_next && S.next(ui + 2, nn);
        int raw[2][2];
        if constexpr (GATHER) { const Unit lu = has_nn ? nn : cur; PG8_LOADRAW(raw, lu); }
        if (wr == 0) PG8_BAR;
        if constexpr (FP8) { asm volatile("s_nop 15\n\ts_nop 15" ::: "memory"); PG8_SCHED; }
        E(acc, cur, wr, wc, fr, fq);
        if (!has_next) break;
        cur = nxt; cA = nA; cB = nB; ++ui;
#pragma unroll
        for (int h = 0; h < 2; ++h) { vcur[h][0] = vnxt[h][0]; vcur[h][1] = vnxt[h][1]; }
        if constexpr (GATHER) {
            asm volatile("s_waitcnt vmcnt(%4)" : "+v"(raw[0][0]), "+v"(raw[0][1]), "+v"(raw[1][0]), "+v"(raw[1][1]) : "n"(Epi::VM_OPS) : "memory");
            if (has_nn) {
#pragma unroll
            for (int h = 0; h < 2; ++h)
#pragma unroll
                for (int i = 0; i < 2; ++i) vnxt[h][i] = (unsigned)(raw[h][i] * K + stC[i]) * 2u; } }
        nxt = nn; has_next = has_nn;
        if (wr == 1) PG8_BAR;
    }
    PG8_WAIT_V(0);
    PG8_BAR;
#undef PG8_SA
#undef PG8_SB
#undef PG8_STAGE
#undef PG8_STAGE_X
#undef PG8_STAGE_A
#undef PG8_LDA
#undef PG8_LDB
#undef PG8_MMA
#undef PG8_LO
#undef PG8_HI
#undef PG8_LOADRAW
#undef PG8_KITER
#undef PG8_WAIT_V
#undef PG8_WAIT_L
#undef PG8_BAR
#undef PG8_SCHED
#undef PG8_LOADVO
}

struct EpiProj {
    static constexpr bool PERM = true;
    bf16_t *Q, *Kb, *V, *P; const f32x2* tab; const float *gq, *gk;
    __device__ __forceinline__ void operator()(const f32x4 (&acc)[2][2][4][2], const Unit& u, int wr, int wc, int fr, int fq) const {
        const int kind = u.pn >> 1, tcol = (u.pn & 1) * 256;
        if (kind < 2) {
            const float* gn = kind == 0 ? gq : gk; const float osc = kind == 0 ? QSCALE : 1.0f;
            f32x2 g1[4], g2[4];
#pragma unroll
            for (int q = 0; q < 4; ++q) { g1[q] = (f32x2){gn[8 * fq + 2 * q], gn[8 * fq + 2 * q + 1]} * osc; g2[q] = (f32x2){gn[32 + 8 * fq + 2 * q], gn[32 + 8 * fq + 2 * q + 1]} * osc; }
            const int rbase = u.pm * BM + wr * 64 + fr;
            f32x4 csc[4], csn[4] = {};
            { const int b0 = rbase / L, t0 = rbase - b0 * L; const f32x4* tp = (const f32x4*)(tab + (size_t)t0 * 32 + 8 * fq);
#pragma unroll
              for (int q = 0; q < 4; ++q) csc[q] = tp[q]; }
#pragma unroll
            for (int ai = 0; ai < 2; ++ai)
#pragma unroll
                for (int m = 0; m < 4; ++m) {
                    const int row = rbase + ai * HALF + m * 16; const int b = row / L, t = row - b * L;
                    if (ai * 4 + m < 7) { const int k1 = ai * 4 + m + 1, rown = rbase + (k1 >> 2) * HALF + (k1 & 3) * 16, bn = rown / L, tn = rown - bn * L;
                        const f32x4* tpn = (const f32x4*)(tab + (size_t)tn * 32 + 8 * fq);
#pragma unroll
                        for (int q = 0; q < 4; ++q) csn[q] = tpn[q]; }
                    f32x2 x1[4], x2[4];
#pragma unroll
                    for (int q = 0; q < 4; ++q) { const f32x4 a1 = acc[ai][0][m][q >> 1], a2 = acc[ai][1][m][q >> 1];
                        x1[q] = (q & 1) ? __builtin_shufflevector(a1, a1, 2, 3) : __builtin_shufflevector(a1, a1, 0, 1); x2[q] = (q & 1) ? __builtin_shufflevector(a2, a2, 2, 3) : __builtin_shufflevector(a2, a2, 0, 1); }
                    f32x2 ssp = x1[0] * x1[0];
#pragma unroll
                    for (int q = 1; q < 4; ++q) ssp = __builtin_elementwise_fma(x1[q], x1[q], ssp);
#pragma unroll
                    for (int q = 0; q < 4; ++q) ssp = __builtin_elementwise_fma(x2[q], x2[q], ssp);
                    float ss = ssp.x + ssp.y;
                    { const auto r16 = __builtin_amdgcn_permlane16_swap(__float_as_uint(ss), __float_as_uint(ss), false, false); ss = __uint_as_float(r16[0]) + __uint_as_float(r16[1]);
                      const auto r32_ = __builtin_amdgcn_permlane32_swap(__float_as_uint(ss), __float_as_uint(ss), false, false); ss = __uint_as_float(r32_[0]) + __uint_as_float(r32_[1]); }
                    const float rstd = rsqrtf(ss * (1.0f / 64.0f) + EPS);
                    f32x2 o1[4], o2[4];
#pragma unroll
                    for (int q = 0; q < 4; ++q) { const f32x4 cs = csc[q]; const f32x2 C = __builtin_shufflevector(cs, cs, 0, 1), S = __builtin_shufflevector(cs, cs, 2, 3);
                        const f32x2 y1 = x1[q] * (g1[q] * rstd), y2 = x2[q] * (g2[q] * rstd);
                        o1[q] = __builtin_elementwise_fma(-y2, S, y1 * C); o2[q] = __builtin_elementwise_fma(y1, S, y2 * C); }
                    bf16_t* dst = kind == 0 ? Q + (size_t)row * AW : Kb + ((size_t)b * LP + t) * AW;
                    dst += tcol + 64 * wc + 8 * fq;
                    u32x4 w1, w2; w1.x = pk2(o1[0].x, o1[0].y); w1.y = pk2(o1[1].x, o1[1].y); w1.z = pk2(o1[2].x, o1[2].y); w1.w = pk2(o1[3].x, o1[3].y);
                    w2.x = pk2(o2[0].x, o2[0].y); w2.y = pk2(o2[1].x, o2[1].y); w2.z = pk2(o2[2].x, o2[2].y); w2.w = pk2(o2[3].x, o2[3].y);
                    *(u32x4*)dst = w1; *(u32x4*)(dst + 32) = w2;
#pragma unroll
                    for (int q = 0; q < 4; ++q) csc[q] = csn[q];
                }
        } else {
#pragma unroll
            for (int ai = 0; ai < 2; ++ai)
#pragma unroll
                for (int m = 0; m < 4; ++m) {
                    const int row = u.pm * BM + ai * HALF + wr * 64 + m * 16 + fr; const int b = row / L, t = row - b * L;
                    bf16_t* dst = kind == 2 ? V + ((size_t)b * LP + t) * AW : P + (size_t)row * AW;
                    dst += tcol + wc * 32 + 8 * fq;
#pragma unroll
                    for (int bj = 0; bj < 2; ++bj) { const f32x4 v0 = acc[ai][bj][m][0], v1 = acc[ai][bj][m][1];
                        u32x4 w; w.x = pk2(v0[0], v0[1]); w.y = pk2(v0[2], v0[3]); w.z = pk2(v1[0], v1[1]); w.w = pk2(v1[2], v1[3]);
                        *(u32x4*)(dst + bj * HALF) = w; }
                }
        }
    }
};
struct EpiOut {
    static constexpr bool PERM = true;
    const bf16_t* XN; const float* rinv; const float* g1; bf16_t* H2;
    __device__ __forceinline__ void operator()(const f32x4 (&acc)[2][2][4][2], const Unit& u, int wr, int wc, int fr, int fq) const {
        const int col0 = u.pn * BM + wc * 32 + 8 * fq;
        float gi[2][8];
#pragma unroll
        for (int bj = 0; bj < 2; ++bj)
#pragma unroll
            for (int i = 0; i < 8; ++i) gi[bj][i] = 1.0f / g1[col0 + bj * HALF + i];
        const int rbase = u.pm * BM + wr * 64 + fr;
        u32x4 xc[2], xn[2] = {}; float ric, rin = 0.f;
        { const bf16_t* src = XN + (size_t)rbase * D; xc[0] = *(const u32x4*)(src + col0); xc[1] = *(const u32x4*)(src + col0 + HALF); ric = rinv[rbase]; }
#pragma unroll
        for (int ai = 0; ai < 2; ++ai)
#pragma unroll
            for (int m = 0; m < 4; ++m) {
                const int row = rbase + ai * HALF + m * 16; const float ri = ric;
                bf16_t* dst = H2 + (size_t)row * D;
                if (ai * 4 + m < 7) { const int k1 = ai * 4 + m + 1, rown = rbase + (k1 >> 2) * HALF + (k1 & 3) * 16; const bf16_t* src = XN + (size_t)rown * D;
                    xn[0] = *(const u32x4*)(src + col0); xn[1] = *(const u32x4*)(src + col0 + HALF); rin = rinv[rown]; }
#pragma unroll
                for (int bj = 0; bj < 2; ++bj) { const int c = col0 + bj * HALF; const u32x4 xv = xc[bj];
                    const f32x4 v0 = acc[ai][bj][m][0], v1 = acc[ai][bj][m][1];
                    u32x4 w; w.x = pk2(bf_lo(xv.x) * ri * gi[bj][0] + v0[0], bf_hi(xv.x) * ri * gi[bj][1] + v0[1]); w.y = pk2(bf_lo(xv.y) * ri * gi[bj][2] + v0[2], bf_hi(xv.y) * ri * gi[bj][3] + v0[3]);
                    w.z = pk2(bf_lo(xv.z) * ri * gi[bj][4] + v1[0], bf_hi(xv.z) * ri * gi[bj][5] + v1[1]); w.w = pk2(bf_lo(xv.w) * ri * gi[bj][6] + v1[2], bf_hi(xv.w) * ri * gi[bj][7] + v1[3]);
                    *(u32x4*)(dst + c) = w; }
                xc[0] = xn[0]; xc[1] = xn[1]; ric = rin;
            }
    }
};
struct EpiGU {
    static constexpr bool PERM = true; static constexpr int VM_OPS = 4;
    unsigned char* A2;
    __device__ __forceinline__ static u32x2 group8(const f32x4 (&acc)[2][2][4][2], int ai, int m) {
        f32x2 a[4];
#pragma unroll
        for (int i = 0; i < 4; ++i) { const f32x4 gq = acc[ai][0][m][i >> 1], uq = acc[ai][1][m][i >> 1];
            const f32x2 g2 = (i & 1) ? __builtin_shufflevector(gq, gq, 2, 3) : __builtin_shufflevector(gq, gq, 0, 1), u2 = (i & 1) ? __builtin_shufflevector(uq, uq, 2, 3) : __builtin_shufflevector(uq, uq, 0, 1);
            const f32x2 t = g2 * (-1.4426950408889634f * W8INV);
            f32x2 e; e.x = __builtin_amdgcn_exp2f(t.x); e.y = __builtin_amdgcn_exp2f(t.y);
            const f32x2 cc = {1.0f / (W8INV * W8INV), 1.0f / (W8INV * W8INV)};
            const f32x2 d = __builtin_elementwise_fma(e, cc, cc);
            f32x2 r; r.x = __builtin_amdgcn_rcpf(d.x); r.y = __builtin_amdgcn_rcpf(d.y);
            a[i] = (g2 * u2) * r; }
        u32x2 w; w.x = pk4_fp8(a[0].x, a[0].y, a[1].x, a[1].y); w.y = pk4_fp8(a[2].x, a[2].y, a[3].x, a[3].y); return w;
    }
    __device__ __forceinline__ void operator()(const f32x4 (&acc)[2][2][4][2], const Unit& u, int wr, int wc, int fr, int fq) const {
        unsigned char* const obase = A2 + (size_t)(u.pm * BM + wr * 64 + fr + (fq & 1) * 16) * FF + u.pn * HALF + wc * 32 + 16 * (fq >> 1);
#pragma unroll
        for (int ai = 0; ai < 2; ++ai)
#pragma unroll
            for (int m = 0; m < 4; m += 2) {
                const u32x2 wa = group8(acc, ai, m), wb = group8(acc, ai, m + 1);
                const auto rx = __builtin_amdgcn_permlane16_swap(wa.x, wb.x, false, false), ry = __builtin_amdgcn_permlane16_swap(wa.y, wb.y, false, false);
                u32x4 o; o.x = rx[0]; o.y = ry[0]; o.z = rx[1]; o.w = ry[1];
                *(u32x4*)(obase + (size_t)(ai * HALF + m * 16) * FF) = o;
            }
    }
};
struct EpiDown {
    static constexpr bool PERM = true;
    unsigned char* Y; const float* gate;
    __device__ __forceinline__ void operator()(const f32x4 (&acc)[2][2][4][2], const Unit& u, int wr, int wc, int fr, int fq) const {
        float gvs[2][4];
#pragma unroll
        for (int ai = 0; ai < 2; ++ai)
#pragma unroll
            for (int m = 0; m < 4; ++m) gvs[ai][m] = gate[u.pm * BM + ai * HALF + wr * 64 + m * 16 + fr];
#pragma unroll
        for (int ai = 0; ai < 2; ++ai)
#pragma unroll
            for (int m = 0; m < 4; ++m) {
                const int row = u.pm * BM + ai * HALF + wr * 64 + m * 16 + fr; const float gv = gvs[ai][m] * (W8INV * 16.0f);
                unsigned char* dst = Y + (size_t)row * D + u.pn * BM + wc * 32 + 8 * fq;
#pragma unroll
                for (int bj = 0; bj < 2; ++bj) { const f32x4 v0 = acc[ai][bj][m][0] * gv, v1 = acc[ai][bj][m][1] * gv;
                    u32x2 w; w.x = pk4_fp8(v0[0], v0[1], v0[2], v0[3]); w.y = pk4_fp8(v1[0], v1[1], v1[2], v1[3]);
                    *(u32x2*)(dst + bj * HALF) = w; }
            }
    }
};
}

namespace att {
constexpr int NW = 8, QBLK = 32, KVBLK = 64, NT = LP / KVBLK;
constexpr int LDQ = AW, LDK = AW, LDV = AW, LDO = D;
constexpr int SHM_V = KVBLK * DV * 2  , SHM_K = KVBLK * DH * 2  ;
constexpr int OFF_V = 0, OFF_K = 2 * SHM_V, OFF_WS = OFF_K + 2 * SHM_K, OFF_OST = OFF_WS + NW * 64 * 4, LDS_BYTES = OFF_OST + NW * 8192;
#define KSWZ(row, colB) ((row) * 128 + ((colB) ^ ((((row) >> 1) & 7) << 4)))
#define SBAR() __builtin_amdgcn_sched_barrier(0)
__device__ __forceinline__ int crow(int r, int hi) { return (r & 3) + 8 * (r >> 2) + 4 * hi; }
__device__ __forceinline__ int v_st(int k, int c) { const int kk = (k & ~0xC) | ((k & 4) << 1) | ((k & 8) >> 1); return ((kk >> 3) * 4 + (c >> 5)) * 512 + ((kk & 7) * 32 + (c & 31)) * 2; }
__device__ __forceinline__ int v_rd_base(int lane) { return ((lane & 3) << 3) | (((lane >> 2) & 3) << 6) | (((lane >> 4) & 1) << 5) | (((lane >> 5) & 1) << 8); }
constexpr int v_rd_off(int d0, int ks, int half) { return d0 * 512 + ks * 4096 + half * 2048; }
template <int OFF> __device__ __forceinline__ s16x4 tr_read(int vb) {
    s16x4 r; asm volatile("ds_read_b64_tr_b16 %0, %1 offset:%2" : "=&v"(r) : "v"(vb), "i"(OFF) : "memory"); return r;
}
template <int D0> __device__ __forceinline__ void pv_one(f32x16& od, int vb, bf16x8 pa0, bf16x8 pa1, bf16x8 pa2, bf16x8 pa3) {
    const s16x4 l0 = tr_read<v_rd_off(D0, 0, 0)>(vb), h0 = tr_read<v_rd_off(D0, 0, 1)>(vb), l1 = tr_read<v_rd_off(D0, 1, 0)>(vb), h1 = tr_read<v_rd_off(D0, 1, 1)>(vb);
    const s16x4 l2 = tr_read<v_rd_off(D0, 2, 0)>(vb), h2 = tr_read<v_rd_off(D0, 2, 1)>(vb), l3 = tr_read<v_rd_off(D0, 3, 0)>(vb), h3 = tr_read<v_rd_off(D0, 3, 1)>(vb);
    asm volatile("s_waitcnt lgkmcnt(0)" ::: "memory"); SBAR();
    __builtin_amdgcn_s_setprio(1);
#define PK(Lo, Hi) (bf16x8){Lo[0], Lo[1], Lo[2], Lo[3], Hi[0], Hi[1], Hi[2], Hi[3]}
    od = __builtin_amdgcn_mfma_f32_32x32x16_bf16(PK(l0, h0), pa0, od, 0, 0, 0);
    od = __builtin_amdgcn_mfma_f32_32x32x16_bf16(PK(l1, h1), pa1, od, 0, 0, 0);
    od = __builtin_amdgcn_mfma_f32_32x32x16_bf16(PK(l2, h2), pa2, od, 0, 0, 0);
    od = __builtin_amdgcn_mfma_f32_32x32x16_bf16(PK(l3, h3), pa3, od, 0, 0, 0);
    __builtin_amdgcn_s_setprio(0);
#undef PK
}
__device__ __forceinline__ void pv_tail(f32x16* o, int vb, bf16x8 pa0) {
    const s16x4 l0 = tr_read<v_rd_off(0, 0, 0)>(vb), h0 = tr_read<v_rd_off(0, 0, 1)>(vb), l1 = tr_read<v_rd_off(1, 0, 0)>(vb), h1 = tr_read<v_rd_off(1, 0, 1)>(vb);
    const s16x4 l2 = tr_read<v_rd_off(2, 0, 0)>(vb), h2 = tr_read<v_rd_off(2, 0, 1)>(vb), l3 = tr_read<v_rd_off(3, 0, 0)>(vb), h3 = tr_read<v_rd_off(3, 0, 1)>(vb);
    asm volatile("s_waitcnt lgkmcnt(0)" ::: "memory"); SBAR();
#define PK(Lo, Hi) (bf16x8){Lo[0], Lo[1], Lo[2], Lo[3], Hi[0], Hi[1], Hi[2], Hi[3]}
    o[0] = __builtin_amdgcn_mfma_f32_32x32x16_bf16(PK(l0, h0), pa0, o[0], 0, 0, 0);
    o[1] = __builtin_amdgcn_mfma_f32_32x32x16_bf16(PK(l1, h1), pa0, o[1], 0, 0, 0);
    o[2] = __builtin_amdgcn_mfma_f32_32x32x16_bf16(PK(l2, h2), pa0, o[2], 0, 0, 0);
    o[3] = __builtin_amdgcn_mfma_f32_32x32x16_bf16(PK(l3, h3), pa0, o[3], 0, 0, 0);
#undef PK
}
__device__ __forceinline__ void pv_d0(f32x16* o, int vb, bf16x8 pa0, bf16x8 pa1, bf16x8 pa2, bf16x8 pa3) {
    pv_one<0>(o[0], vb, pa0, pa1, pa2, pa3); pv_one<1>(o[1], vb, pa0, pa1, pa2, pa3); pv_one<2>(o[2], vb, pa0, pa1, pa2, pa3); pv_one<3>(o[3], vb, pa0, pa1, pa2, pa3);
}
__device__ __forceinline__ void qkt(f32x16& p0, f32x16& p1, const LAS char* Ks, const bf16x8* qr, int r32, int hi) {
    p0 = f32x16{}; p1 = f32x16{};
#pragma unroll
    for (int d0 = 0; d0 < 4; ++d0) { const int cb = d0 * 32 + hi * 16;
        const bf16x8 b0 = *(const LAS bf16x8*)(Ks + KSWZ(r32, cb));
        const bf16x8 b1 = *(const LAS bf16x8*)(Ks + KSWZ(32 + r32, cb));
        p0 = __builtin_amdgcn_mfma_f32_32x32x16_bf16(b0, qr[d0], p0, 0, 0, 0);
        p1 = __builtin_amdgcn_mfma_f32_32x32x16_bf16(b1, qr[d0], p1, 0, 0, 0); }
}
__device__ __forceinline__ void partialSM(f32x16& p0) {
#pragma unroll
    for (int r = 0; r < 16; ++r) p0[r] = __builtin_amdgcn_exp2f(p0[r]);
}
template <bool MASK> __device__ __forceinline__ void finishSM(f32x16& p0, f32x16& p1, float& l_reg, bf16x8& pa0, bf16x8& pa1, bf16x8& pa2, bf16x8& pa3) {
    if constexpr (MASK) {
#pragma unroll
        for (int r = 8; r < 16; ++r) p0[r] = 0.f;
#pragma unroll
        for (int r = 0; r < 16; ++r) p1[r] = 0.f;
    } else {
#pragma unroll
        for (int r = 0; r < 16; ++r) p1[r] = __builtin_amdgcn_exp2f(p1[r]);
    }
    float ps = 0.f;
#pragma unroll
    for (int r = 0; r < 16; ++r) ps += p0[r];
#pragma unroll
    for (int r = 0; r < 16; ++r) ps += p1[r];
    l_reg += ps;
#define PK4(P, BASE, OUT) do { v4u w = {pk2(P[BASE + 0], P[BASE + 1]), pk2(P[BASE + 2], P[BASE + 3]), pk2(P[BASE + 4], P[BASE + 5]), pk2(P[BASE + 6], P[BASE + 7])}; \
    OUT = __builtin_bit_cast(bf16x8, w); } while (0)
    PK4(p0, 0, pa0); PK4(p0, 8, pa1); PK4(p1, 0, pa2); PK4(p1, 8, pa3);
#undef PK4
}

constexpr int KSLOT = SHM_K, VSLOT = SHM_V, OFF_KR = 0, OFF_VR = 3 * KSLOT, OFF_WS2 = OFF_VR + 4 * VSLOT, OFF_ST = OFF_WS2 + NW * 64 * 4, LDS_BYTES2 = OFF_ST + NW * 8192;
#define WAIT_BAR(N) asm volatile("s_waitcnt vmcnt(" #N ") lgkmcnt(0)\n\ts_barrier" ::: "memory")
struct MixArgs { bf16* MIX; const bf16* P; const float* subg; float lam; int b, h, q0; };
template <int MODE>
__device__ __forceinline__ void attn_unit(const bf16* __restrict__ Qb, const bf16* __restrict__ Kg, const bf16* __restrict__ Vg, bf16* __restrict__ Ob, int ldo, int nrows, const MixArgs ma, LAS char* lds, bool pre_in = false, bool pre_out = false) {
    int tid_ = threadIdx.x; asm volatile("" : "+v"(tid_));
    const int tid = tid_, wid = __builtin_amdgcn_readfirstlane(tid >> 6), lane = tid & 63, r32 = lane & 31, hi = lane >> 5;
    LAS char* K_lds = lds + OFF_KR; LAS char* V_lds = lds + OFF_VR;
    LAS float* wsf = (LAS float*)(lds + OFF_WS2) + wid * 64;
    LAS bf16* stg = (LAS bf16*)(lds + wid * 8192);
    const bool active = wid * QBLK < nrows;
    int qrow = wid * QBLK + r32; qrow = qrow < nrows ? qrow : nrows - 1;
    const char* Qc = (const char*)Qb; char* Oc = (char*)Ob;
    const unsigned qo = (unsigned)(qrow * LDQ + hi * 8) * 2u;
    const int krow = 8 * wid + (lane >> 3);
    const unsigned ksrc = (unsigned)(krow * LDK + (((lane & 7) ^ ((krow >> 1) & 7)) * 8)) * 2u;
    unsigned vsrc[2];
#pragma unroll
    for (int i = 0; i < 2; ++i) { const int p = wid + 8 * i, s = 2 * p + (lane >> 5), kk = (s >> 2) * 8 + ((lane & 31) >> 2), k = kk  , c = (s & 3) * 32 + (lane & 3) * 8;
        vsrc[i] = (unsigned)(k * LDV + c) * 2u; }
    const char* Vc = (const char*)Vg;
    const int vb0 = (int)(unsigned)(uintptr_t)V_lds + v_rd_base(lane);
    LAS bf16* stash = (LAS bf16*)(lds + OFF_ST + wid * 8192);
#pragma unroll 1
    for (int mp = 0; mp < (MODE ? 2 : 1); ++mp) {
    const char* Kc = (const char*)Kg + mp * (DH * 2);
    float l_reg = 0.f; f32x16 o[4] = {}; bf16x8 qr[4];
#pragma unroll
    for (int d0 = 0; d0 < 4; ++d0) qr[d0] = *(const bf16x8*)(Qc + qo + mp * (DH * 2) + d0 * 32);
#define DMA_TILE(t, ks, vs) DMA_TILE_K(Kc, t, ks, vs)
#define DMA_TILE_K(KC, t, ks, vs) do { const char* kt_ = (KC) + (size_t)(t) * (KVBLK * LDK * 2); const char* vt_ = Vc + (size_t)(t) * (KVBLK * LDV * 2); \
    __builtin_amdgcn_global_load_lds((const unsigned*)(kt_ + ksrc), (LAS unsigned*)(K_lds + (ks) + wid * 1024), 16, 0, 0); \
    __builtin_amdgcn_global_load_lds((const unsigned*)(vt_ + vsrc[0]), (LAS unsigned*)(V_lds + (vs) + wid * 1024), 16, 0, 0); \
    __builtin_amdgcn_global_load_lds((const unsigned*)(vt_ + vsrc[1]), (LAS unsigned*)(V_lds + (vs) + (wid + 8) * 1024), 16, 0, 0); } while (0)
    f32x16 pA0, pA1, pB0, pB1; bf16x8 pa0, pa1, pa2, pa3;
    int ks_c = 0, vs_c = 0;
    int vs_p = 0;
    int ks_n2 = 2 * KSLOT, vs_n2 = 2 * VSLOT;
#define ROT() do { vs_p = vs_c; ks_c = (ks_c == 2 * KSLOT) ? 0 : ks_c + KSLOT; vs_c = (vs_c == 3 * VSLOT) ? 0 : vs_c + VSLOT; \
    ks_n2 = (ks_n2 == 2 * KSLOT) ? 0 : ks_n2 + KSLOT; vs_n2 = (vs_n2 == 3 * VSLOT) ? 0 : vs_n2 + VSLOT; } while (0)
    if (!(MODE == 1 && (mp == 1 || pre_in))) { DMA_TILE(0, 0, 0); DMA_TILE(1, KSLOT, VSLOT); }
    WAIT_BAR(3);
    if (active) { qkt(pA0, pA1, K_lds, qr, r32, hi); partialSM(pA0); }
    DMA_TILE(2, 2 * KSLOT, 2 * VSLOT);
    WAIT_BAR(5);
    ROT();
#pragma unroll 1
    for (int j = 1; j + 1 < NT; j += 2) {
        if (j + 2 < NT) DMA_TILE(j + 2, ks_n2, vs_n2);
        if (active) {
            SBAR(); qkt(pB0, pB1, K_lds + ks_c, qr, r32, hi);
            finishSM<false>(pA0, pA1, l_reg, pa0, pa1, pa2, pa3); SBAR();
            pv_d0(o, vb0 + vs_p, pa0, pa1, pa2, pa3); partialSM(pB0);
        }
        if (j + 2 < NT) WAIT_BAR(5); else WAIT_BAR(0);
        ROT();
        if (j + 3 < NT) DMA_TILE(j + 3, ks_n2, vs_n2);
        if (active) {
            SBAR(); qkt(pA0, pA1, K_lds + ks_c, qr, r32, hi);
            finishSM<false>(pB0, pB1, l_reg, pa0, pa1, pa2, pa3); SBAR();
            pv_d0(o, vb0 + vs_p, pa0, pa1, pa2, pa3); partialSM(pA0);
        }
        if (j + 3 < NT) WAIT_BAR(5); else WAIT_BAR(0);
        ROT();
    }
    if (active) {
        finishSM<true>(pA0, pA1, l_reg, pa0, pa1, pa2, pa3); SBAR();
        pv_tail(o, vb0 + vs_p, pa0);
    }
    WAIT_BAR(0);
    if (MODE == 1 && mp == 0) { const char* Kc1 = (const char*)Kg + (DH * 2);
        DMA_TILE_K(Kc1, 0, 0, 0); DMA_TILE_K(Kc1, 1, KSLOT, VSLOT); }
    int lane2 = lane; asm volatile("" : "+v"(lane2));
    const int r32e = lane2 & 31, hie = lane2 >> 5;
    if (active) {
        { auto rr = __builtin_amdgcn_permlane32_swap(__float_as_uint(l_reg), __float_as_uint(l_reg), false, false); l_reg = __uint_as_float(rr[0]) + __uint_as_float(rr[1]); }
        const float rl = 1.0f / l_reg;
        LAS char* sbase = (LAS char*)((MODE == 1 && mp == 0) ? (LAS char*)stash : (LAS char*)stg) + r32e * 256;
        LAS char* rbase = (LAS char*)stash + r32e * 256;
#pragma unroll
        for (int d0 = 0; d0 < 4; ++d0)
#pragma unroll
            for (int g4 = 0; g4 < 4; ++g4) { const int dv0 = 32 * d0 + 8 * g4 + 4 * hie; const int off = ((((dv0 >> 3) ^ (r32e & 15))) << 4) + (dv0 & 7) * 2;
                float v[4];
#pragma unroll
                for (int j = 0; j < 4; ++j) v[j] = o[d0][4 * g4 + j] * rl;
                if (MODE == 1 && mp == 1) { const pg8::u32x2 s2 = *(const LAS pg8::u32x2*)(rbase + off);
                    v[0] = bf_lo(s2.x) - ma.lam * v[0]; v[1] = bf_hi(s2.x) - ma.lam * v[1]; v[2] = bf_lo(s2.y) - ma.lam * v[2]; v[3] = bf_hi(s2.y) - ma.lam * v[3]; }
                pg8::u32x2 w2; w2.x = pk2(v[0], v[1]); w2.y = pk2(v[2], v[3]);
                *(LAS pg8::u32x2*)(sbase + off) = w2; }
        asm volatile("s_waitcnt lgkmcnt(0)" ::: "memory");
        if (!(MODE == 1 && mp == 0)) {
            const int ch = lane2 & 15;
            if (MODE == 0) {
#pragma unroll
                for (int i = 0; i < 8; ++i) { const int row = i * 4 + (lane2 >> 4); const v4u v = *(const LAS v4u*)((LAS char*)stg + row * 256 + ((ch ^ (row & 15)) << 4));
                    if (wid * QBLK + row < nrows) *(v4u*)(Oc + (unsigned)((wid * QBLK + row) * ldo + ch * 8) * 2u) = v; }
            } else {
                float sg[8];
#pragma unroll
                for (int i = 0; i < 8; ++i) sg[i] = ma.subg[8 * ch + i] * (1.0f - LAM_INIT);
                bf16* mrow = ma.MIX + ((size_t)ma.b * L + ma.q0 + wid * QBLK) * D + ma.h * DV + ch * 8;
#pragma unroll
                for (int i = 0; i < 8; ++i) { const int row = i * 4 + (lane2 >> 4); const v4u v = *(const LAS v4u*)((LAS char*)stg + row * 256 + ((ch ^ (row & 15)) << 4));
                    float x[8]; float ss = 0.f;
#pragma unroll
                    for (int q = 0; q < 4; ++q) { x[2 * q] = bf_lo(v[q]); x[2 * q + 1] = bf_hi(v[q]); ss += x[2 * q] * x[2 * q] + x[2 * q + 1] * x[2 * q + 1]; }
                    ss = row16_sum(ss);
                    const float rstd = rsqrtf(ss * (1.0f / DV) + EPS);
                    v4u w;
#pragma unroll
                    for (int q = 0; q < 4; ++q) w[q] = pk2(x[2 * q] * rstd * sg[2 * q], x[2 * q + 1] * rstd * sg[2 * q + 1]);
                    *(v4u*)(mrow + (size_t)row * D) = w; }
            }
        }
    }
    WAIT_BAR(0);
#undef DMA_TILE
#undef ROT
    }
    if (MODE == 1) {
        if (pre_out) { const char* Kc0 = (const char*)Kg;
            DMA_TILE_K(Kc0, 0, 0, 0); DMA_TILE_K(Kc0, 1, KSLOT, VSLOT); }
#undef DMA_TILE_K
        int tid3 = threadIdx.x; asm volatile("" : "+v"(tid3)); const int tid = tid3, lane = tid3 & 63;
        constexpr int SLAB_OFF = 86 * 1024;
        const int w2 = 1 << ma.h; const bf16* Pb = ma.P + (size_t)ma.b * L * AW + ma.h * 128;
        { v4u tmp[9];
#pragma unroll
          for (int q = 0; q < 9; ++q) { const int i = tid + q * 512; int t = ma.q0 - 8 + (i >> 4); t = t < 0 ? 0 : (t >= L ? L - 1 : t); tmp[q] = *(const v4u*)(Pb + (size_t)t * AW + (i & 15) * 8); }
#pragma unroll
          for (int q = 0; q < 9; ++q) { const int i = tid + q * 512; if (i < 272 * 16) *(LAS v4u*)(lds + SLAB_OFF + (i >> 4) * 256 + (i & 15) * 16) = tmp[q]; } }
        asm volatile("s_waitcnt lgkmcnt(0)\n\ts_barrier" ::: "memory");
        const int ch = lane & 15;
        bf16* mrow = ma.MIX + ((size_t)ma.b * L + ma.q0 + wid * QBLK) * D + 512 + ma.h * 128 + ch * 8;
        { const int row0 = wid * QBLK + (lane >> 4) * 8, t00 = ma.q0 + row0;
          float S[8];
#pragma unroll
          for (int q = 0; q < 8; ++q) S[q] = 0.f;
          const LAS char* sb0 = lds + SLAB_OFF + (row0 + 8) * 256 + ch * 16;
#define POOL_ADD(U, SGN) do { const int u_ = (U); if (u_ >= 0 && u_ < L) { const v4u pv_ = *(const LAS v4u*)(sb0 + (u_ - t00) * 256); \
              _Pragma("unroll") for (int q = 0; q < 4; ++q) { S[2 * q] += (SGN) * bf_lo(pv_[q]); S[2 * q + 1] += (SGN) * bf_hi(pv_[q]); } } } while (0)
          for (int k = -w2; k < w2; ++k) POOL_ADD(t00 + k, 1.0f);
#pragma unroll 1
          for (int i = 0; i < 8; ++i) { const int t = t00 + i;
              if (i) { POOL_ADD(t + w2 - 1, 1.0f); POOL_ADD(t - 1 - w2, -1.0f); }
              const int lo = (t - w2) > 0 ? (t - w2) : 0, hi2 = (t + w2) < L ? (t + w2) : L;
              const float inv = 1.0f / (float)(hi2 - lo);
              const v4u pt = *(const LAS v4u*)(sb0 + i * 256);
              v4u wp;
#pragma unroll
              for (int q = 0; q < 4; ++q) wp[q] = pk2(S[2 * q] * inv - bf_lo(pt[q]), S[2 * q + 1] * inv - bf_hi(pt[q]));
              *(v4u*)(mrow + (size_t)((lane >> 4) * 8 + i) * D) = wp; }
#undef POOL_ADD
        }
        WAIT_BAR(0);
    }
}

__device__ __forceinline__ void attn_rem_unit(const bf16* __restrict__ Qb, const bf16* __restrict__ Kg, const bf16* __restrict__ Vg, bf16* __restrict__ Ob, int nrows, LAS char* lds) {
    int tid_ = threadIdx.x; asm volatile("" : "+v"(tid_));
    const int tid = tid_, wid = __builtin_amdgcn_readfirstlane(tid >> 6), lane = tid & 63, r32 = lane & 31, hi = lane >> 5;
    LAS char* slot = lds + wid * 16384;
    LAS float* lpart = (LAS float*)(lds + 131072);
    LAS unsigned short* ostage = (LAS unsigned short*)(lds + 131072 + 1024);
    const int qrow = r32 < nrows ? r32 : nrows - 1;
    const char* Qc = (const char*)Qb + (unsigned)(qrow * LDQ + hi * 8) * 2u;
    bf16x8 qr[4];
#pragma unroll
    for (int d0 = 0; d0 < 4; ++d0) qr[d0] = *(const bf16x8*)(Qc + d0 * 32);
    const int vb = (int)(unsigned)(uintptr_t)slot + v_rd_base(lane);
    f32x16 o[4] = {}; float l_reg = 0.f;
#pragma unroll 1
    for (int t = wid; t < NT; t += NW) {
        const char* vt = (const char*)Vg + (size_t)t * (KVBLK * LDV * 2);
#pragma unroll
        for (int p = 0; p < 16; ++p) { const int s = 2 * p + (lane >> 5), kk = (s >> 2) * 8 + ((lane & 31) >> 2), c = (s & 3) * 32 + (lane & 3) * 8;
            __builtin_amdgcn_global_load_lds((const unsigned*)(vt + (unsigned)(kk * LDV + c) * 2u), (LAS unsigned*)(slot + p * 1024), 16, 0, 0); }
        const char* kt = (const char*)Kg + (size_t)t * (KVBLK * LDK * 2) + (unsigned)(r32 * LDK) * 2u + hi * 16;
        bf16x8 b0[4], b1[4];
#pragma unroll
        for (int d0 = 0; d0 < 4; ++d0) { b0[d0] = *(const bf16x8*)(kt + d0 * 32); b1[d0] = *(const bf16x8*)(kt + 32 * LDK * 2 + d0 * 32); }
        f32x16 p0 = {}, p1 = {};
#pragma unroll
        for (int d0 = 0; d0 < 4; ++d0) { p0 = __builtin_amdgcn_mfma_f32_32x32x16_bf16(b0[d0], qr[d0], p0, 0, 0, 0); p1 = __builtin_amdgcn_mfma_f32_32x32x16_bf16(b1[d0], qr[d0], p1, 0, 0, 0); }
        partialSM(p0);
        bf16x8 pa0, pa1, pa2, pa3;
        asm volatile("s_waitcnt vmcnt(0)" ::: "memory");
        if (t == NT - 1) { finishSM<true>(p0, p1, l_reg, pa0, pa1, pa2, pa3); SBAR(); pv_tail(o, vb, pa0); }
        else { finishSM<false>(p0, p1, l_reg, pa0, pa1, pa2, pa3); SBAR(); pv_d0(o, vb, pa0, pa1, pa2, pa3); }
        asm volatile("s_waitcnt lgkmcnt(0)" ::: "memory");
    }
    { auto rr = __builtin_amdgcn_permlane32_swap(__float_as_uint(l_reg), __float_as_uint(l_reg), false, false); l_reg = __uint_as_float(rr[0]) + __uint_as_float(rr[1]); }
#pragma unroll
    for (int d0 = 0; d0 < 4; ++d0)
#pragma unroll
        for (int r = 0; r < 16; ++r) *(LAS float*)(slot + ((d0 * 16 + r) * 64 + lane) * 4) = o[d0][r];
    if (hi == 0) lpart[wid * 32 + r32] = l_reg;
    asm volatile("s_waitcnt lgkmcnt(0)\n\ts_barrier" ::: "memory");
    { float lt = 0.f;
#pragma unroll
      for (int w = 0; w < NW; ++w) lt += lpart[w * 32 + r32];
      const float rl = 1.0f / lt; const int d0 = wid >> 1;
#pragma unroll
      for (int i = 0; i < 8; ++i) { const int r = 8 * (wid & 1) + i; float sum = 0.f;
#pragma unroll
          for (int w = 0; w < NW; ++w) sum += *(const LAS float*)(lds + w * 16384 + ((d0 * 16 + r) * 64 + lane) * 4);
          const int dv = 32 * d0 + (r & 3) + 8 * (r >> 2) + 4 * hi;
          if (r32 < 16) ostage[r32 * DV + dv] = (unsigned short)(pk2(sum * rl, 0.f) & 0xffffu); } }
    asm volatile("s_waitcnt lgkmcnt(0)\n\ts_barrier" ::: "memory");
    if (wid == 0) {
#pragma unroll
        for (int i = 0; i < 4; ++i) { const int ch = i * 64 + lane; const v4u v = *(const LAS v4u*)((LAS char*)ostage + ch * 16);
            if ((ch >> 4) < nrows) *(v4u*)((char*)Ob + ch * 16) = v; }
    }
    asm volatile("s_waitcnt lgkmcnt(0)\n\ts_barrier" ::: "memory");
}
#undef WAIT_BAR
#undef KSWZ
#undef SBAR
}

constexpr size_t MiB = 1u << 20;
constexpr size_t WS_CTL = 0, CTL_ZERO_BYTES = 64 * 1024;
constexpr size_t WS_TAB = 1 * MiB;
constexpr size_t WS_AFF = 2 * MiB;
constexpr size_t WS_SLOT = 7 * MiB;
constexpr size_t WS_ROWIDX = 12 * MiB, WS_ROWGATE = 13 * MiB;
constexpr size_t WS_RINV = 14 * MiB;
constexpr size_t WS_WIN = 16 * MiB, WS_WOUT = 20 * MiB;
constexpr size_t WS_WD = 24 * MiB, WS_WGU = 88 * MiB;
constexpr size_t WS_XN = 216 * MiB;
constexpr size_t WS_BIG = 352 * MiB;
constexpr size_t WS_Q = WS_BIG, WS_K = WS_BIG + 65 * MiB, WS_V = WS_BIG + 131 * MiB, WS_P = WS_BIG + 197 * MiB, WS_OA = WS_BIG + 262 * MiB, WS_MIX = WS_BIG + 392 * MiB;
constexpr size_t WS_A2 = WS_BIG;
constexpr size_t WS_Y = 88 * MiB;
constexpr size_t WS_H2 = WS_A2 + (size_t)MT * FF * 2;
constexpr size_t WS_END = WS_H2 + (size_t)M * D * 2;
static_assert(WS_Y + (size_t)MT * D * 2 <= WS_BIG && WS_XN + (size_t)M * D * 2 <= WS_BIG && WS_MIX + (size_t)M * D * 2 <= WS_H2 && WS_END <= 1024 * MiB, "d_ws map");
static_assert(WS_K + (size_t)BATCH * LP * AW * 2 <= WS_V && WS_V + (size_t)BATCH * LP * AW * 2 <= WS_P && WS_P + (size_t)M * AW * 2 <= WS_OA && WS_OA + (size_t)M * D * 2 <= WS_MIX, "d_ws map 2");
constexpr int CW_BAR = 4096, CW_PAIR = 8192;

constexpr int RING_BYTES = 131072, LDSCTL_OFF = 159744, MISC_OFF = LDSCTL_OFF + 320, LDS_BYTES = 163840;
constexpr int NWAVES = 8, NPHASE = 10;

#define XB_TMO      128
#define XB_XCNT(j)  (256  + 64 * (j))
#define XB_XSUB(j)  (1280 + 64 * (j))
#define XB_XGEN(j)  (2304 + 64 * (j))
#define XB_TOP      3328
#define XB_TOPGEN   3392
#define XCD_BAR_WORDS 3456
#define XB_SPIN_CAP (1u << 22)
__device__ __forceinline__ unsigned xb_ld(unsigned* p)              { return __hip_atomic_load(p, __ATOMIC_RELAXED, __HIP_MEMORY_SCOPE_AGENT); }
__device__ __forceinline__ unsigned xb_add(unsigned* p, unsigned v) { return __hip_atomic_fetch_add(p, v, __ATOMIC_RELAXED, __HIP_MEMORY_SCOPE_AGENT); }
__device__ __forceinline__ unsigned xb_xcc_id() { return (unsigned)__builtin_amdgcn_s_getreg((3 << 11) | 20) & 0xFu; }
#define XB_SPIN(cond, bar) do { unsigned _sp = 0; while (cond) { __builtin_amdgcn_s_sleep(1); \
    if ((++_sp & 255u) == 0u) { if (xb_ld(&(bar)[XB_TMO])) break; if (_sp > XB_SPIN_CAP) { atomicAdd(&(bar)[XB_TMO], 1u); break; } } } } while (0)
struct XcdBarrier { unsigned* bar; unsigned x; volatile LAS unsigned* st; };
__device__ __forceinline__ XcdBarrier xcd_barrier_post(unsigned* bar, volatile LAS unsigned* st) {
    XcdBarrier b; b.bar = bar; b.x = xb_xcc_id(); b.st = st;
    if (threadIdx.x == 0) (void)xb_add(&bar[XB_XCNT(b.x)], 1u);
    return b;
}
__device__ __forceinline__ void xcd_barrier_complete(unsigned* bar, unsigned x, unsigned& nloc, unsigned& nx) {
    const unsigned G = gridDim.x * gridDim.y * gridDim.z;
    unsigned sum, cnt, mine, sp = 0u;
    for (;;) {
        sum = 0u; cnt = 0u; mine = 0u;
#pragma unroll
        for (unsigned j = 0; j < 16; ++j) { const unsigned c = xb_ld(&bar[XB_XCNT(j)]); sum += c; cnt += (c > 0u) ? 1u : 0u; mine = (j == x) ? c : mine; }
        if (sum == G) break;
        __builtin_amdgcn_s_sleep(1);
        if ((++sp & 255u) == 0u) { if (xb_ld(&bar[XB_TMO])) break; if (sp > XB_SPIN_CAP) { atomicAdd(&bar[XB_TMO], 1u); break; } }
    }
    nloc = mine > 0u ? mine : 1u; nx = cnt > 0u ? cnt : 1u;
}
__device__ __forceinline__ void xcd_barrier(const XcdBarrier& b) {
    asm volatile("s_waitcnt vmcnt(0)" ::: "memory");
    __syncthreads();
    if (threadIdx.x == 0) {
        unsigned* bar = b.bar;
        __builtin_amdgcn_s_waitcnt(0);
        unsigned nloc = b.st[0], nx = b.st[1];
        if (nloc == 0u) { xcd_barrier_complete(bar, b.x, nloc, nx); b.st[0] = nloc; b.st[1] = nx; }
        const unsigned old = xb_add(&bar[XB_XSUB(b.x)], 1u);
        const unsigned gen = old / nloc;
        if (old + 1u == (gen + 1u) * nloc) {
            __builtin_amdgcn_fence(__ATOMIC_RELEASE, "agent");
            asm volatile("s_waitcnt vmcnt(0)" ::: "memory");
            const unsigned og = xb_add(&bar[XB_TOP], 1u);
            const unsigned tg = og / nx;
            if (og + 1u == (tg + 1u) * nx) xb_add(&bar[XB_TOPGEN], 1u);
            else XB_SPIN(xb_ld(&bar[XB_TOPGEN]) == tg, bar);
            __builtin_amdgcn_fence(__ATOMIC_ACQUIRE, "agent");
            xb_add(&bar[XB_XGEN(b.x)], 1u);
            asm volatile("s_waitcnt vmcnt(0)" ::: "memory");
        } else {
            XB_SPIN(xb_ld(&bar[XB_XGEN(b.x)]) == gen, bar);
            __builtin_amdgcn_fence(__ATOMIC_ACQUIRE, "agent");
            asm volatile("s_waitcnt vmcnt(0)" ::: "memory");
        }
    }
    __syncthreads();
}

struct Frame {
    LAS unsigned char* lds;
    volatile LAS unsigned* MISC;
    int tid, lane, wave, vcu, G;
    const float *x, *meta, *ln1g, *w_in, *qng, *kng, *lq1, *lk1, *lq2, *lk2, *subg, *poolw, *pools, *w_out, *ln2g, *w_router, *w_gate, *w_up, *w_down;
    float* out; unsigned char* ws;
};

template <class RowMap>
__device__ __forceinline__ void p0_transpose_item(const float* W, int N, bf16* WT, int ldd, int k0, int n0, RowMap rm, LAS float* scr, int lane) {
    { float rv[32]; const float* wp = W + (size_t)(k0 + (lane >> 5)) * N + n0 + (lane & 31);
#pragma unroll
      for (int i = 0; i < 32; ++i) rv[i] = __builtin_nontemporal_load(wp + (size_t)(2 * i) * N);
#pragma unroll
      for (int i = 0; i < 32; ++i) scr[(2 * i + (lane >> 5)) * 33 + (lane & 31)] = rv[i]; }
    LDS_WAIT(); asm volatile("" ::: "memory");
    const int c = lane & 7;
#pragma unroll
    for (int j = 0; j < 4; ++j) { const int n = (lane >> 3) + 8 * j; const LAS float* s = scr + (8 * c) * 33 + n;
        v4u o; o.x = pk2(s[0 * 33], s[1 * 33]); o.y = pk2(s[2 * 33], s[3 * 33]); o.z = pk2(s[4 * 33], s[5 * 33]); o.w = pk2(s[6 * 33], s[7 * 33]);
        *(v4u*)(WT + (size_t)rm(n0 + n) * ldd + k0 + 8 * c) = o; }
    LDS_WAIT(); asm volatile("" ::: "memory");
}
template <class RowMap>
__device__ __forceinline__ void p0_transpose_item8(const float* W, int N, unsigned char* WT8, int ldd, int k0, int n0, RowMap rm, LAS float* scr, int lane) {
    { float rv[32]; const float* wp = W + (size_t)(k0 + (lane >> 5)) * N + n0 + (lane & 31);
#pragma unroll
      for (int i = 0; i < 32; ++i) rv[i] = __builtin_nontemporal_load(wp + (size_t)(2 * i) * N);
#pragma unroll
      for (int i = 0; i < 32; ++i) scr[(2 * i + (lane >> 5)) * 33 + (lane & 31)] = rv[i]; }
    LDS_WAIT(); asm volatile("" ::: "memory");
    const int n = lane >> 1, kh = (lane & 1) * 32; const LAS float* s = scr + kh * 33 + n;
    unsigned char* dst = WT8 + (size_t)rm(n0 + n) * ldd + k0 + kh;
#pragma unroll
    for (int q = 0; q < 2; ++q) { v4u o;
#pragma unroll
        for (int d = 0; d < 4; ++d) { const LAS float* p = s + (q * 16 + d * 4) * 33; o[d] = pk4_fp8(p[0] * W8SCALE, p[33] * W8SCALE, p[66] * W8SCALE, p[99] * W8SCALE); }
        *(v4u*)(dst + q * 16) = o; }
    LDS_WAIT(); asm volatile("" ::: "memory");
}
struct RmIn { __device__ __forceinline__ int operator()(int n) const { if (n >= 1024) return n; const int w = n & 255; return (n & ~255) + (((w >> 5) & 1) << 7) + ((w >> 6) << 5) + (w & 31); } };
struct RmId { __device__ __forceinline__ int operator()(int n) const { return n; } };
struct RmGU { int half; __device__ __forceinline__ int operator()(int f) const { return ((f >> 7) << 8) + (half << 7) + (f & 127); } };

constexpr int MOE_IG = (D / 64) * (FF / 32), MOE_ID = (FF / 64) * (D / 32), MOE_PER = 2 * MOE_IG + MOE_ID, MOE_ITEMS = NE * MOE_PER;
constexpr int MOE_P0 = 18432, MOE_F1 = 33792;
struct MoeItem { const float* wp; size_t n; unsigned char* dst; };
__device__ __forceinline__ MoeItem moe_item_ref(const Frame& F, int it, int lane) {
    unsigned char* Wgu_t = F.ws + WS_WGU; unsigned char* Wd_t = F.ws + WS_WD;
    const int e = it / MOE_PER; int r = it - e * MOE_PER;
    const float* W; int N, ldd, k0, n0, row; unsigned char* WT8;
    const int nl = lane >> 1;
    if (r < 2 * MOE_IG) { const int half = r >= MOE_IG; r -= half * MOE_IG; const int nb = FF / 32; W = (half ? F.w_up : F.w_gate) + (size_t)e * D * FF; N = FF; WT8 = Wgu_t + (size_t)e * 2 * FF * D; ldd = D;
        k0 = 64 * (r / nb); n0 = 32 * (r % nb); row = RmGU{half}(n0 + nl); }
    else { r -= 2 * MOE_IG; const int nb = D / 32; W = F.w_down + (size_t)e * FF * D; N = D; WT8 = Wd_t + (size_t)e * D * FF; ldd = FF; k0 = 64 * (r / nb); n0 = 32 * (r % nb); row = n0 + nl; }
    MoeItem m; m.wp = W + (size_t)(k0 + (lane >> 5)) * N + n0 + (lane & 31); m.n = (size_t)N; m.dst = WT8 + (size_t)row * ldd + k0 + (lane & 1) * 32; return m;
}
__device__ __forceinline__ void moe_item_load(const MoeItem& m, float (&rv)[32]) {
#pragma unroll
    for (int i = 0; i < 32; ++i) rv[i] = __builtin_nontemporal_load(m.wp + (size_t)(2 * i) * m.n);
}
__device__ __forceinline__ void moe_item_finish(const MoeItem& m, const float (&rv)[32], LAS float* scr, int lane) {
#pragma unroll
    for (int i = 0; i < 32; ++i) scr[(2 * i + (lane >> 5)) * 33 + (lane & 31)] = rv[i];
    LDS_WAIT(); asm volatile("" ::: "memory");
    const int n = lane >> 1, kh = (lane & 1) * 32; const LAS float* s = scr + kh * 33 + n;
#pragma unroll
    for (int q = 0; q < 2; ++q) { v4u o;
#pragma unroll
        for (int d = 0; d < 4; ++d) { const LAS float* p = s + (q * 16 + d * 4) * 33; o[d] = pk4_fp8(p[0] * W8SCALE, p[33] * W8SCALE, p[66] * W8SCALE, p[99] * W8SCALE); }
        *(v4u*)(m.dst + q * 16) = o; }
    LDS_WAIT(); asm volatile("" ::: "memory");
}
__device__ __forceinline__ void p0_moe_items(Frame& F, int lo, int hi, int gw, int ngw) {
    LAS float* scr = (LAS float*)(F.lds + F.wave * 16384); const int lane = F.lane;
    int it = lo + gw; if (it >= hi) return;
    MoeItem c = moe_item_ref(F, it, lane); float rv[32]; moe_item_load(c, rv);
    for (;;) {
        const int nx = it + ngw; const bool has = nx < hi;
        const MoeItem nm = moe_item_ref(F, has ? nx : it, lane); float rn[32];
        moe_item_load(nm, rn);
        moe_item_finish(c, rv, scr, lane);
        if (!has) break;
        c = nm; it = nx;
#pragma unroll
        for (int i = 0; i < 32; ++i) rv[i] = rn[i];
    }
}
__device__ __forceinline__ void p0_prologue(Frame& F) {
    LAS float* scr = (LAS float*)(F.lds + F.wave * 16384);
    const int gw = F.vcu * NWAVES + F.wave, NGW = F.G * NWAVES, lane = F.lane;
    bf16* Win_t = (bf16*)(F.ws + WS_WIN); bf16* Wout_t = (bf16*)(F.ws + WS_WOUT);
    constexpr int I_IN = (D / 64) * (NIN / 32), I_OUT = (512 / 64) * (D / 32);
    for (int it = gw; it < I_IN + I_OUT; it += NGW) {
        int r = it;
        if (r < I_IN) { const int nb = NIN / 32; p0_transpose_item(F.w_in, NIN, Win_t, D, 64 * (r / nb), 32 * (r % nb), RmIn{}, scr, lane); continue; } r -= I_IN;
        { const int nb = D / 32; p0_transpose_item(F.w_out, D, Wout_t, D, 64 * (r / nb), 32 * (r % nb), RmId{}, scr, lane); }
    }
    p0_moe_items(F, 0, MOE_P0, gw, NGW);
    for (int it = gw; it < 512 * (D / 64); it += NGW) {
        const int kq = it / (D / 64), n = (it % (D / 64)) * 64 + lane, g = kq >> 7;
        const float* pw = F.poolw + (size_t)kq * 128; const float* ps = F.pools + g * 128; const float* wo = F.w_out + (size_t)(512 + g * 128) * D + n;
        float a = 0.f;
#pragma unroll 32
        for (int j = 0; j < 128; ++j) a += pw[j] * ps[j] * wo[(size_t)j * D];
        Wout_t[(size_t)n * D + 512 + kq] = (bf16)(pk2(a, 0.f) & 0xffffu);
    }
    bf16* XN = (bf16*)(F.ws + WS_XN);
    auto rowsrc = [&](int r) -> const f32x4* { const int b = r / L, t = r - b * L; return (const f32x4*)(t < NMETA ? F.meta + (size_t)t * D : F.x + ((size_t)b * SEQ + (t - NMETA)) * D); };
    if (gw < M) {
        f32x4 v[4], u[4], gg4[4];
#pragma unroll
        for (int j = 0; j < 4; ++j) gg4[j] = ((const f32x4*)F.ln1g)[lane + 64 * j];
        { const f32x4* s0 = rowsrc(gw); const f32x4* s1 = rowsrc(gw + NGW < M ? gw + NGW : gw);
#pragma unroll
          for (int j = 0; j < 4; ++j) { v[j] = __builtin_nontemporal_load(s0 + lane + 64 * j); u[j] = __builtin_nontemporal_load(s1 + lane + 64 * j); } }
        for (int r = gw; r < M; r += 2 * NGW) {
            const int r1 = r + NGW; const bool has1 = r1 < M; const int r1c = has1 ? r1 : r;
            const int n0 = r + 2 * NGW < M ? r + 2 * NGW : r, n1 = r + 3 * NGW < M ? r + 3 * NGW : n0;
            const f32x4* q0 = rowsrc(n0); const f32x4* q1 = rowsrc(n1);
            f32x4 vn[4], un[4];
#pragma unroll
            for (int j = 0; j < 4; ++j) { vn[j] = __builtin_nontemporal_load(q0 + lane + 64 * j); un[j] = __builtin_nontemporal_load(q1 + lane + 64 * j); }
            float ss = 0.f, su = 0.f;
#pragma unroll
            for (int j = 0; j < 4; ++j) { ss += (v[j][0] * v[j][0] + v[j][1] * v[j][1]) + (v[j][2] * v[j][2] + v[j][3] * v[j][3]); su += (u[j][0] * u[j][0] + u[j][1] * u[j][1]) + (u[j][2] * u[j][2] + u[j][3] * u[j][3]); }
            const float ms0 = wave_sum(ss) * (1.0f / D) + EPS, ms1 = wave_sum(su) * (1.0f / D) + EPS;
            const float rs0 = rsqrtf(ms0), rs1 = rsqrtf(ms1);
            if (lane == 0) { float* RINV = (float*)(F.ws + WS_RINV); RINV[r] = sqrtf(ms0); if (has1) RINV[r1c] = sqrtf(ms1); }
            unsigned long long* o0 = (unsigned long long*)(XN + (size_t)r * D) + lane; unsigned long long* o1 = (unsigned long long*)(XN + (size_t)r1c * D) + lane;
#pragma unroll
            for (int j = 0; j < 4; ++j) { const f32x4 gg = gg4[j]; const f32x4 y = v[j] * rs0 * gg, z = u[j] * rs1 * gg;
                o0[64 * j] = (unsigned long long)pk2(y[0], y[1]) | ((unsigned long long)pk2(y[2], y[3]) << 32);
                if (has1) o1[64 * j] = (unsigned long long)pk2(z[0], z[1]) | ((unsigned long long)pk2(z[2], z[3]) << 32); }
#pragma unroll
            for (int j = 0; j < 4; ++j) { v[j] = vn[j]; u[j] = un[j]; }
        }
    }
    f32x2* tab = (f32x2*)(F.ws + WS_TAB);
    for (int i = gw * 64 + lane; i < L * 32; i += NGW * 64) {
        const int t = i >> 5, k = i & 31; const float fr = exp2f(-(float)k * (13.287712379549449f / 32.0f));
        float s, c; sincosf((float)t * fr, &s, &c); float* tf = (float*)tab + (size_t)t * 64 + (k >> 1) * 4 + (k & 1); tf[0] = c; tf[2] = s;
    }
    bf16* Kb = (bf16*)(F.ws + WS_K); bf16* Vb = (bf16*)(F.ws + WS_V);
    for (int i = gw * 64 + lane; i < BATCH * (LP - L) * (AW / 8); i += NGW * 64) {
        const int ch = i % (AW / 8), rr = i / (AW / 8), b = rr / (LP - L), t = L + rr % (LP - L); const size_t o = ((size_t)b * LP + t) * AW + ch * 8;
        *(v4u*)(Kb + o) = (v4u){0u, 0u, 0u, 0u}; *(v4u*)(Vb + o) = (v4u){0u, 0u, 0u, 0u};
    }
}

__device__ __forceinline__ void p5_rows(Frame& F) {
    const int gw = F.vcu * NWAVES + F.wave, NGW = F.G * NWAVES, lane = F.lane, tid = F.tid;
    constexpr int WROW = 2064;
    LAS unsigned char* whi = F.lds; LAS unsigned char* wlo = F.lds + 16 * WROW; LAS float* g2s = (LAS float*)(F.lds + 32 * WROW);
    { f32x4 wv[8]; float gv[8];
#pragma unroll
      for (int q = 0; q < 8; ++q) { const int k = (tid >> 2) + 128 * q; wv[q] = *(const f32x4*)(F.w_router + (size_t)k * NE + 4 * (tid & 3)); gv[q] = F.ln2g[k]; }
#pragma unroll
      for (int q = 0; q < 8; ++q) { const int k = (tid >> 2) + 128 * q;
#pragma unroll
          for (int j = 0; j < 4; ++j) { const int e = 4 * (tid & 3) + j; const float w = wv[q][j] * gv[q];
              const unsigned hb = pk2(w, 0.f) & 0xffffu; const float rem = w - __uint_as_float(hb << 16);
              *(LAS bf16*)(whi + e * WROW + k * 2) = (bf16)hb; *(LAS bf16*)(wlo + e * WROW + k * 2) = (bf16)(pk2(rem, 0.f) & 0xffffu); }
          if ((tid & 3) == 0) g2s[k] = gv[q]; } }
    __syncthreads();
    unsigned char* XN8 = F.ws + WS_XN; float* AFF = (float*)(F.ws + WS_AFF); const bf16* H2 = (const bf16*)(F.ws + WS_H2);
    const int ri = lane & 15, g = lane >> 4;
    const bool spread = (F.G == 256);
    const int nfull = (M / 16) / NGW;
    for (int it = 0;; ++it) {
        int grp;
        if (!spread || it < nfull) { grp = gw + it * NGW; if (grp >= M / 16) break; }
        else { const int j = F.vcu >> 3; if (it > nfull || F.wave != 0 || (F.vcu & 7) != (j & 7) || nfull * NGW + j >= M / 16) break; grp = nfull * NGW + j; }
        const int row = grp * 16 + ri;
        const v4u* src = (const v4u*)(H2 + (size_t)row * D + 8 * g);
        v4u x[32];
#pragma unroll
        for (int s = 0; s < 32; ++s) x[s] = src[4 * s];
        f32x4 acc = (f32x4){0.f, 0.f, 0.f, 0.f}; float ss = 0.f;
#pragma unroll
        for (int s = 0; s < 32; ++s) {
            const bf16x8 bh = *(const LAS bf16x8*)(whi + ri * WROW + (32 * s + 8 * g) * 2), bl = *(const LAS bf16x8*)(wlo + ri * WROW + (32 * s + 8 * g) * 2);
            const bf16x8 af = __builtin_bit_cast(bf16x8, x[s]);
            acc = __builtin_amdgcn_mfma_f32_16x16x32_bf16(af, bh, acc, 0, 0, 0);
            acc = __builtin_amdgcn_mfma_f32_16x16x32_bf16(af, bl, acc, 0, 0, 0);
#pragma unroll
            for (int q = 0; q < 4; ++q) { const float lo = bf_lo(x[s][q]), hi = bf_hi(x[s][q]); ss += lo * lo + hi * hi; }
            if (s & 1) __builtin_amdgcn_sched_barrier(0);
        }
        ss = swap32_sum(swap16_sum(ss));
        const float rstd = rsqrtf(ss * (1.0f / D) + EPS);
        unsigned char* dst = XN8 + (size_t)row * D + 8 * g;
#pragma unroll
        for (int s = 0; s < 32; ++s) { const f32x4 ga = *(const LAS f32x4*)(g2s + 32 * s + 8 * g), gb = *(const LAS f32x4*)(g2s + 32 * s + 8 * g + 4);
            asm volatile("" : "+v"(x[s]));
            pg8::u32x2 w;
            const f32x2 y0 = ((f32x2){bf_lo(x[s][0]), bf_hi(x[s][0])} * __builtin_shufflevector(ga, ga, 0, 1)) * rstd, y1 = ((f32x2){bf_lo(x[s][1]), bf_hi(x[s][1])} * __builtin_shufflevector(ga, ga, 2, 3)) * rstd;
            const f32x2 y2 = ((f32x2){bf_lo(x[s][2]), bf_hi(x[s][2])} * __builtin_shufflevector(gb, gb, 0, 1)) * rstd, y3 = ((f32x2){bf_lo(x[s][3]), bf_hi(x[s][3])} * __builtin_shufflevector(gb, gb, 2, 3)) * rstd;
            w.x = pk4_fp8(y0.x, y0.y, y1.x, y1.y); w.y = pk4_fp8(y2.x, y2.y, y3.x, y3.y);
            *(pg8::u32x2*)(dst + 32 * s) = w;
            if (s & 1) __builtin_amdgcn_sched_barrier(0); }
#pragma unroll
        for (int r = 0; r < 4; ++r) { const float lg = acc[r] * __shfl(rstd, 4 * g + r);
            const float mx = row16_max(lg);
            const float ex = __expf(lg - mx); const float sm = row16_sum(ex);
            AFF[(size_t)(grp * 16 + 4 * g + r) * NE + ri] = ex / sm; }
    }
    __syncthreads();
}

__device__ __forceinline__ void p6_select(Frame& F) {
    LAS unsigned* key = (LAS unsigned*)F.lds;
    LAS unsigned* const key2 = key;
    LAS unsigned* hist = key + 2 * 2080;
    LAS unsigned* sel = hist + 768;
    LAS unsigned* wtot = sel + 8;
    const float* AFF = (const float*)(F.ws + WS_AFF); int* SLOT = (int*)(F.ws + WS_SLOT); int* ROWIDX = (int*)(F.ws + WS_ROWIDX); float* ROWGATE = (float*)(F.ws + WS_ROWGATE);
    const int tid = F.tid, lane = F.lane, wid = F.wave;
    for (int pr = F.vcu; pr < BATCH * NE / 2; pr += F.G) {
      const int b = pr >> 3, e0 = pr & 7;
      { float kv[5], kw[5];
#pragma unroll
        for (int q = 0; q < 5; ++q) { const int t = tid + q * NWAVES * 64; const float* ap = AFF + ((size_t)b * L + (t < L ? t : L - 1)) * NE + e0; kv[q] = ap[0]; kw[q] = ap[8]; }
#pragma unroll
        for (int q = 0; q < 5; ++q) { const int t = tid + q * NWAVES * 64; if (t < L) { key2[t] = __float_as_uint(kv[q]); key2[2080 + t] = __float_as_uint(kw[q]); } } }
      for (int z = 0; z < 2; ++z) {
        const int e = e0 + 8 * z; LAS unsigned* key = key2 + z * 2080;
        unsigned prefix = 0u, maskbits = 0u, need = CAP;
        if (tid < 256) hist[tid] = 0u;
        __syncthreads();
        int hb = 0;
#pragma unroll 1
        for (int pass = 0; pass < 4; ++pass) { const int shift = pass < 3 ? 22 - 8 * pass : 0;
            LAS unsigned* hc = hist + hb * 256; const int hn = hb == 2 ? 0 : hb + 1;
            if (tid < 256) hist[hn * 256 + tid] = 0u;
            for (int t = tid; t < L; t += NWAVES * 64) { const unsigned k = key[t]; if ((k & maskbits) == prefix) atomicAdd((unsigned*)&hc[(k >> shift) & 255u], 1u); }
            __syncthreads();
            unsigned c[4], s4 = 0u;
#pragma unroll
            for (int q = 0; q < 4; ++q) { c[q] = hc[255 - (4 * lane + q)]; s4 += c[q]; }
            const unsigned incl = wave_scan_incl(s4, lane);
            const unsigned excl = incl - s4;
            const bool mine = excl < need && need <= incl;
            unsigned dgl = 0u, nnl = 0u;
            if (mine) { unsigned cum = excl; bool found = false;
#pragma unroll
                for (int q = 0; q < 4; ++q) { if (!found && cum + c[q] >= need) { dgl = 255u - (unsigned)(4 * lane + q); nnl = need - cum; found = true; } if (!found) cum += c[q]; } }
            const int src = __builtin_ctzll(__ballot(mine));
            const unsigned dg = (unsigned)__builtin_amdgcn_readlane((int)dgl, src); need = (unsigned)__builtin_amdgcn_readlane((int)nnl, src);
            prefix |= dg << shift; maskbits |= 255u << shift;
            hb = hn;
        }
        const int t0 = tid * 5;
        unsigned cg = 0u, ce = 0u;
#pragma unroll
        for (int i = 0; i < 5; ++i) { const int t = t0 + i; if (t < L) { const unsigned k = key[t]; cg += (k > prefix) ? 1u : 0u; ce += (k == prefix) ? 1u : 0u; } }
        const unsigned pk = cg | (ce << 16); const unsigned incl = wave_scan_incl(pk, lane);
        if (lane == 63) wtot[wid] = incl;
        __syncthreads();
        unsigned base = 0u;
        for (int w = 0; w < wid; ++w) base += wtot[w];
        unsigned excl = base + incl - pk;
        unsigned gb = excl & 0xffffu, eb = excl >> 16;
#pragma unroll
        for (int i = 0; i < 5; ++i) { const int t = t0 + i; if (t < L) { const unsigned k = key[t]; const bool isg = k > prefix, ise = k == prefix;
            const bool s = isg || (ise && eb < need); const unsigned slot = gb + (eb < need ? eb : need);
            SLOT[((size_t)b * L + t) * NE + e] = s ? (int)slot : -1;
            if (s) { ROWIDX[(size_t)e * EP + b * CAP + slot] = b * L + t; ROWGATE[(size_t)e * EP + b * CAP + slot] = __uint_as_float(k); }
            gb += isg ? 1u : 0u; eb += ise ? 1u : 0u; } }
        if (b == 0) for (int i = tid; i < EP - ER; i += NWAVES * 64) { ROWIDX[(size_t)e * EP + ER + i] = 0; ROWGATE[(size_t)e * EP + ER + i] = 0.f; }
        __syncthreads();
      }
    }
}

__device__ __forceinline__ void p9_combine(Frame& F) {
    const int gw = F.vcu * NWAVES + F.wave, NGW = F.G * NWAVES, lane = F.lane;
    const int* SLOT = (const int*)(F.ws + WS_SLOT); const unsigned char* Y = F.ws + WS_Y; const bf16* H2 = (const bf16*)(F.ws + WS_H2);
    typedef unsigned u32x2v __attribute__((ext_vector_type(2)));
#define ACC8(A0, A1, W) do { A0[0] += bf_lo(W[0]); A0[1] += bf_hi(W[0]); A0[2] += bf_lo(W[1]); A0[3] += bf_hi(W[1]); A1[0] += bf_lo(W[2]); A1[1] += bf_hi(W[2]); A1[2] += bf_lo(W[3]); A1[3] += bf_hi(W[3]); } while (0)
#define ACCF8(A0, A1, W) do { const f32x2 c0_ = __builtin_amdgcn_cvt_pk_f32_fp8((int)W[0], false), c1_ = __builtin_amdgcn_cvt_pk_f32_fp8((int)W[0], true), \
        c2_ = __builtin_amdgcn_cvt_pk_f32_fp8((int)W[1], false), c3_ = __builtin_amdgcn_cvt_pk_f32_fp8((int)W[1], true); \
        A0[0] += c0_[0]; A0[1] += c0_[1]; A0[2] += c1_[0]; A0[3] += c1_[1]; A1[0] += c2_[0]; A1[1] += c2_[1]; A1[2] += c3_[0]; A1[3] += c3_[1]; } while (0)
    v4u h0 = (v4u){0u, 0u, 0u, 0u}, h1 = h0; int sl = -1;
    if (gw < BATCH * SEQ) { const int b = gw / SEQ, t = NMETA + (gw - b * SEQ); const bf16* hr = H2 + ((size_t)b * L + t) * D;
        h0 = __builtin_nontemporal_load((const v4u*)(hr + 8 * lane)); h1 = __builtin_nontemporal_load((const v4u*)(hr + 512 + 8 * lane)); sl = lane < NE ? SLOT[((size_t)b * L + t) * NE + lane] : -1; }
    for (int r = gw; r < BATCH * SEQ; r += NGW) {
        const int b = r / SEQ;
        float* orow = F.out + (size_t)r * D;
        f32x4 a[4], ym[4];
#pragma unroll
        for (int j = 0; j < 4; ++j) { a[j] = (f32x4){0.f, 0.f, 0.f, 0.f}; ym[j] = a[j]; }
        ACC8(a[0], a[1], h0); ACC8(a[2], a[3], h1);
        unsigned long long mk = __ballot(sl >= 0);
        u32x2v y0[4], y1[4];
#pragma unroll
        for (int q = 0; q < 4; ++q) { y0[q] = (u32x2v){0u, 0u}; y1[q] = y0[q];
            if (mk) { const int e = __builtin_ctzll(mk); mk &= mk - 1; const int s = __builtin_amdgcn_readlane(sl, e); const unsigned char* yr = Y + ((size_t)e * EP + b * CAP + s) * D;
                y0[q] = __builtin_nontemporal_load((const u32x2v*)(yr + 8 * lane)); y1[q] = __builtin_nontemporal_load((const u32x2v*)(yr + 512 + 8 * lane)); } }
        const int slc = sl;
        const int rn = r + NGW;
        if (rn < BATCH * SEQ) { const int bn = rn / SEQ, tn = NMETA + (rn - bn * SEQ); const bf16* hr = H2 + ((size_t)bn * L + tn) * D;
            h0 = __builtin_nontemporal_load((const v4u*)(hr + 8 * lane)); h1 = __builtin_nontemporal_load((const v4u*)(hr + 512 + 8 * lane)); sl = lane < NE ? SLOT[((size_t)bn * L + tn) * NE + lane] : -1; }
#pragma unroll
        for (int q = 0; q < 4; ++q) { ACCF8(ym[0], ym[1], y0[q]); ACCF8(ym[2], ym[3], y1[q]); }
        while (mk) { const int e = __builtin_ctzll(mk); mk &= mk - 1; const int s = __builtin_amdgcn_readlane(slc, e);
            const unsigned char* yr = Y + ((size_t)e * EP + b * CAP + s) * D;
            const u32x2v z0 = *(const u32x2v*)(yr + 8 * lane), z1 = *(const u32x2v*)(yr + 512 + 8 * lane);
            ACCF8(ym[0], ym[1], z0); ACCF8(ym[2], ym[3], z1); }
#pragma unroll
        for (int j = 0; j < 4; ++j) ((f32x4*)orow)[2 * lane + (j & 1) + 128 * (j >> 1)] = a[j] + ym[j] * (1.0f / 16.0f);
    }
#undef ACC8
#undef ACCF8
}

struct Args { const float* in[19]; float* out; unsigned char* ws; int ph_lo, ph_hi; };
__global__ void __launch_bounds__(NWAVES * 64, 2) mk_fwd(Args args) {
    extern __shared__ __attribute__((aligned(16))) unsigned char lds[];
    Frame F;
    F.lds = (LAS unsigned char*)lds;
    F.MISC = (volatile LAS unsigned*)(F.lds + MISC_OFF);
    F.tid = threadIdx.x; F.lane = F.tid & 63; F.wave = __builtin_amdgcn_readfirstlane(F.tid >> 6);
    F.G = gridDim.x; { const int bx = blockIdx.x; F.vcu = (F.G % 8 == 0) ? (bx % 8) * (F.G / 8) + bx / 8 : bx; }
    F.x = args.in[0]; F.meta = args.in[1]; F.ln1g = args.in[2]; F.w_in = args.in[3]; F.qng = args.in[4]; F.kng = args.in[5]; F.lq1 = args.in[6]; F.lk1 = args.in[7];
    F.lq2 = args.in[8]; F.lk2 = args.in[9]; F.subg = args.in[10]; F.poolw = args.in[11]; F.pools = args.in[12]; F.w_out = args.in[13]; F.ln2g = args.in[14];
    F.w_router = args.in[15]; F.w_gate = args.in[16]; F.w_up = args.in[17]; F.w_down = args.in[18]; F.out = args.out; F.ws = args.ws;
    unsigned char* ws = args.ws;
    for (int u = F.tid; u < (LDS_BYTES - LDSCTL_OFF) / 4; u += NWAVES * 64) ((LAS unsigned*)(F.lds + LDSCTL_OFF))[u] = 0u;
    __syncthreads();
    XcdBarrier bar; bar.bar = (unsigned*)(ws + WS_CTL) + CW_BAR; bar.x = 0; bar.st = nullptr;
    if (MK_N_LAUNCHES == 1) bar = xcd_barrier_post((unsigned*)(ws + WS_CTL) + CW_BAR, F.MISC + 8);
    const int lo = args.ph_lo, hi = args.ph_hi;
#ifndef PH_MASK
#define PH_MASK 0x3ff
#endif
#define IN(k) (((PH_MASK >> (k)) & 1) && lo <= (k) && (k) < hi)
#define SEAM(k) do { if (IN(k) && IN((k) + 1)) xcd_barrier(bar); } while (0)
#ifndef PROBE_REP
#define PROBE_REP 0
#endif
#define REP(k) for (int _r = 0; _r <= ((PROBE_REP >> (k)) & 1); ++_r, (_r <= ((PROBE_REP >> (k)) & 1)) ? xcd_barrier(bar) : (void)0)

    if (IN(0)) REP(0) { p0_prologue(F); } SEAM(0);

    if (IN(1)) REP(1) {
        pg8::Gemm g{(const bf16*)(ws + WS_XN), (const bf16*)(ws + WS_WIN), D, nullptr}; pg8::StaticOrder S; S.init(M / 256, NIN / 256, F.G, (int)blockIdx.x, 0);
        pg8::EpiProj E{(bf16*)(ws + WS_Q), (bf16*)(ws + WS_K), (bf16*)(ws + WS_V), (bf16*)(ws + WS_P), (const f32x2*)(ws + WS_TAB), F.qng, F.kng};
        pg8::gemm_phase<pg8::EpiProj, false>(F.lds, g, S, E);
        { const int nx = (M / 256) * (NIN / 256) % F.G;
          if ((int)blockIdx.x >= nx) p0_moe_items(F, MOE_P0, MOE_F1, ((int)blockIdx.x - nx) * NWAVES + F.wave, (F.G - nx) * NWAVES); }
    } SEAM(1);

    if (IN(2)) REP(2) {
        const bf16* Q = (const bf16*)(ws + WS_Q); const bf16* Kb = (const bf16*)(ws + WS_K); const bf16* Vb = (const bf16*)(ws + WS_V); const bf16* Pp = (const bf16*)(ws + WS_P);
        bf16* MIX = (bf16*)(ws + WS_MIX); bf16* OAR = (bf16*)(ws + WS_OA);
        unsigned* pcnt = (unsigned*)(ws + WS_CTL) + CW_PAIR;
        const int lane = F.lane, wid = F.wave;
        const float lam = __expf(wave_sum(F.lq1[lane] * F.lk1[lane])) - __expf(wave_sum(F.lq2[lane] * F.lk2[lane])) + LAM_INIT;
        for (int s = F.vcu; s < BATCH * NH * 2; s += F.G) {
            const int p = s >> 1, c = s & 1, b = p >> 2, h = p & 3;
            const bf16* Kh = Kb + (size_t)b * LP * AW + 2 * h * DH; const bf16* Vh = Vb + (size_t)b * LP * AW + h * DV;
            for (int u = 0; u < 4; ++u) {
                const int q0 = (4 * c + u) * 256;
                const att::MixArgs ma{MIX, Pp, F.subg, lam, b, h, q0};
                att::attn_unit<1>(Q + ((size_t)b * L + q0) * AW + 2 * h * DH, Kh, Vh, nullptr, 0, 256, ma, (LAS char*)F.lds, u > 0, u < 3);
            }
            {
                const att::MixArgs ma0{MIX, Pp, F.subg, lam, b, h, 8 * 256};
                att::attn_rem_unit(Q + ((size_t)b * L + 2048) * AW + (2 * h + c) * DH, Kh + c * DH, Vh, OAR + (size_t)(p * 2 + c) * 16 * DV, L - 2048, (LAS char*)F.lds);
                int lane_r = threadIdx.x & 63; asm volatile("" : "+v"(lane_r));
                const int row = 2 * wid + (lane_r >> 5), t = 2048 + row, cq = (lane_r & 31) * 4;
                if (c == 0) {
                    const int w2 = 1 << h; const bf16* Pb = Pp + (size_t)b * L * AW + h * 128 + cq;
                    const int lo = t - w2, hi2 = (t + w2) < L ? (t + w2) : L;
                    float acc[4] = {0.f, 0.f, 0.f, 0.f};
                    for (int k = -w2; k < w2; ++k) { const int tt = t + k; const bool in = tt < hi2; const f32x2 pv = *(const f32x2*)(Pb + (size_t)(in ? tt : t) * AW); const float mk = in ? 1.0f : 0.0f;
                        const unsigned w0 = __float_as_uint(pv[0]), w1 = __float_as_uint(pv[1]);
                        acc[0] += mk * bf_lo(w0); acc[1] += mk * bf_hi(w0); acc[2] += mk * bf_lo(w1); acc[3] += mk * bf_hi(w1); }
                    const float inv = 1.0f / (float)(hi2 - lo);
                    const f32x2 pc = *(const f32x2*)(Pb + (size_t)t * AW); const unsigned c0 = __float_as_uint(pc[0]), c1 = __float_as_uint(pc[1]);
                    pg8::u32x2 wp; wp.x = pk2(acc[0] * inv - bf_lo(c0), acc[1] * inv - bf_hi(c0)); wp.y = pk2(acc[2] * inv - bf_lo(c1), acc[3] * inv - bf_hi(c1));
                    *(pg8::u32x2*)(MIX + ((size_t)b * L + t) * D + 512 + h * 128 + cq) = wp;
                }
                __syncthreads();
                if (F.tid == 0) { __builtin_amdgcn_fence(__ATOMIC_RELEASE, "agent"); asm volatile("s_waitcnt vmcnt(0)" ::: "memory");
                    const unsigned old = __hip_atomic_fetch_add(pcnt + p, 1u, __ATOMIC_RELAXED, __HIP_MEMORY_SCOPE_AGENT);
                    if (old == 1u) { __builtin_amdgcn_fence(__ATOMIC_ACQUIRE, "agent"); asm volatile("s_waitcnt vmcnt(0)" ::: "memory"); }
                    F.MISC[16] = old; }
                __syncthreads();
                if (F.MISC[16] == 1u) {
                    const bf16* o0 = OAR + (size_t)(p * 2) * 16 * DV + row * DV + cq; const bf16* o1 = o0 + 16 * DV;
                    const f32x2 a0 = *(const f32x2*)o0, a1 = *(const f32x2*)o1;
                    const unsigned x0 = __float_as_uint(a0[0]), x1 = __float_as_uint(a0[1]), y0 = __float_as_uint(a1[0]), y1 = __float_as_uint(a1[1]);
                    float d[4] = {bf_lo(x0) - lam * bf_lo(y0), bf_hi(x0) - lam * bf_hi(y0), bf_lo(x1) - lam * bf_lo(y1), bf_hi(x1) - lam * bf_hi(y1)};
                    float ss = (d[0] * d[0] + d[1] * d[1]) + (d[2] * d[2] + d[3] * d[3]);
                    ss = swap16_sum(row16_sum(ss));
                    const float rstd = rsqrtf(ss * (1.0f / DV) + EPS) * (1.0f - LAM_INIT);
                    pg8::u32x2 w; w.x = pk2(d[0] * rstd * F.subg[cq], d[1] * rstd * F.subg[cq + 1]); w.y = pk2(d[2] * rstd * F.subg[cq + 2], d[3] * rstd * F.subg[cq + 3]);
                    *(pg8::u32x2*)(MIX + ((size_t)b * L + t) * D + h * DV + cq) = w;
                }
                __syncthreads();
            }
        }
    } SEAM(2);

    if (IN(4)) REP(4) {
        pg8::Gemm g{(const bf16*)(ws + WS_MIX), (const bf16*)(ws + WS_WOUT), D, nullptr}; pg8::StaticOrder S; S.init(M / 256, D / 256, F.G, (int)blockIdx.x, 0);
        pg8::EpiOut E{(const bf16*)(ws + WS_XN), (const float*)(ws + WS_RINV), F.ln1g, (bf16*)(ws + WS_H2)};
        pg8::gemm_phase<pg8::EpiOut, false>(F.lds, g, S, E);
        { const int nx = (M / 256) * (D / 256) % F.G;
          if ((int)blockIdx.x >= nx) p0_moe_items(F, MOE_F1, MOE_ITEMS, ((int)blockIdx.x - nx) * NWAVES + F.wave, (F.G - nx) * NWAVES); }
    } SEAM(4);

    if (IN(5)) REP(5) { p5_rows(F); } SEAM(5);
    if (IN(6)) REP(6) { p6_select(F); } SEAM(6);

    if (IN(7)) REP(7) {
        pg8::Gemm g{(const bf16*)(ws + WS_XN), (const bf16*)(ws + WS_WGU), D / 2, (const int*)(ws + WS_ROWIDX)}; pg8::StaticOrder S; S.init(MT / 256, 2 * FF / 256, F.G, (int)blockIdx.x, EP / 256);
        pg8::EpiGU E{ws + WS_A2};
        pg8::gemm_phase<pg8::EpiGU, true, 1>(F.lds, g, S, E);
    } SEAM(7);

    if (IN(8)) REP(8) {
        pg8::Gemm g{(const bf16*)(ws + WS_A2), (const bf16*)(ws + WS_WD), FF / 2, nullptr}; pg8::StaticOrder S; S.init(MT / 256, D / 256, F.G, (int)blockIdx.x, EP / 256);
        pg8::EpiDown E{ws + WS_Y, (const float*)(ws + WS_ROWGATE)};
        pg8::gemm_phase<pg8::EpiDown, false, 1, false, true>(F.lds, g, S, E);
    } SEAM(8);

    if (IN(9)) { p9_combine(F); }
#undef IN
#undef SEAM
}

extern "C" void kernel_launch(void* const* d_in, const int* in_sizes, int n_in, void* d_out, int out_size, void* d_ws, size_t ws_size, hipStream_t stream) {
    static int grid = 0;
    if (grid == 0) {
        if (n_in != 19 || in_sizes[0] != BATCH * SEQ * D || out_size != BATCH * SEQ * D || ws_size < WS_END) {
            fprintf(stderr, "kernel_launch: unexpected shapes (n_in %d, in0 %d, out %d, ws %zu < %zu)\n", n_in, n_in > 0 ? in_sizes[0] : -1, out_size, ws_size, (size_t)WS_END); grid = -1; return; }
        int dev = 0, cus = 0;
        if (hipGetDevice(&dev) != hipSuccess || hipDeviceGetAttribute(&cus, hipDeviceAttributeMultiprocessorCount, dev) != hipSuccess) { grid = -1; return; }
        if (hipFuncSetAttribute((const void*)mk_fwd, hipFuncAttributeMaxDynamicSharedMemorySize, LDS_BYTES) != hipSuccess) { fprintf(stderr, "kernel_launch: hipFuncSetAttribute failed\n"); grid = -1; return; }
        (void)hipGetLastError();
        grid = cus;
    }
    if (grid < 0) return;
    if (hipMemsetAsync((char*)d_ws + WS_CTL, 0, CTL_ZERO_BYTES, stream) != hipSuccess) { fprintf(stderr, "kernel_launch: memset failed\n"); return; }
    Args a{};
    for (int i = 0; i < 19; ++i) a.in[i] = (const float*)d_in[i];
    a.out = (float*)d_out; a.ws = (unsigned char*)d_ws;
#if defined(PROBE_LO)
    { const int seg[3][2] = {{0, 9}, {PROBE_LO, PROBE_HI}, {9, 10}};
      for (int li = 0; li < 3; ++li) { a.ph_lo = seg[li][0]; a.ph_hi = seg[li][1]; hipLaunchKernelGGL(mk_fwd, dim3(grid), dim3(NWAVES * 64), LDS_BYTES, stream, a); }
      return; }
#endif
    for (int li = 0; li < MK_N_LAUNCHES; ++li) {
        a.ph_lo = (MK_N_LAUNCHES == 1) ? 0 : li; a.ph_hi = (MK_N_LAUNCHES == 1) ? NPHASE : li + 1;
        hipLaunchKernelGGL(mk_fwd, dim3(grid), dim3(NWAVES * 64), LDS_BYTES, stream, a);
        const hipError_t le = hipPeekAtLastError();
        if (le != hipSuccess) { fprintf(stderr, "kernel_launch: launch %d failed: %s\n", li, hipGetErrorName(le)); break; }
    }
}
```

```cpp
#include <hip/hip_runtime.h>
#include <cstdio>
#include <cstdint>

#ifndef MK_N_LAUNCHES
#define MK_N_LAUNCHES 1
#endif

constexpr int BATCH = 32, SEQ = 2048, NMETA = 16, L = SEQ + NMETA  , LP = 2112  , D = 1024;
constexpr int M = BATCH * L;
constexpr int NIN = 2048, AW = 512, NH = 4, DH = 64, DV = 128;
constexpr int NE = 16, CAP = 258, ER = BATCH * CAP  , EP = 8448  , FF = 2048, MT = NE * EP;
constexpr float EPS = 1e-6f;
constexpr float QSCALE = 0.125f * 1.4426950408889634f;
constexpr float LAM_INIT = 0.2f;

#define GAS __attribute__((address_space(1)))
#define LAS __attribute__((address_space(3)))
typedef unsigned short bf16;
typedef unsigned v4u __attribute__((ext_vector_type(4)));
typedef float f32x4 __attribute__((ext_vector_type(4)));
typedef float f32x2 __attribute__((ext_vector_type(2)));
typedef float f32x16 __attribute__((ext_vector_type(16)));
typedef short bf16x8 __attribute__((ext_vector_type(8)));
typedef short s16x4 __attribute__((ext_vector_type(4)));
typedef __bf16 bf16x2_t __attribute__((ext_vector_type(2)));
typedef GAS unsigned gu32;
#define RLX_AGENT __ATOMIC_RELAXED, __HIP_MEMORY_SCOPE_AGENT
#define LDS_WAIT() asm volatile("s_waitcnt lgkmcnt(0)" ::: "memory")
#define VM_WAIT() asm volatile("s_waitcnt vmcnt(0)" ::: "memory")
__device__ __forceinline__ unsigned pk2(float lo, float hi) { f32x2 v = {lo, hi}; bf16x2_t b = __builtin_convertvector(v, bf16x2_t); return __builtin_bit_cast(unsigned, b); }
__device__ __forceinline__ unsigned pk4_fp8(float a, float b, float c, float d) { int w = __builtin_amdgcn_cvt_pk_fp8_f32(a, b, 0, false); w = __builtin_amdgcn_cvt_pk_fp8_f32(c, d, w, true); return (unsigned)w; }
constexpr float W8SCALE = 64.0f, W8INV = 1.0f / 64.0f;
__device__ __forceinline__ float bf_lo(unsigned w) { return __uint_as_float(w << 16); }
__device__ __forceinline__ float bf_hi(unsigned w) { return __uint_as_float(w & 0xffff0000u); }
template <int CTRL> __device__ __forceinline__ float dpp_mov(float v) { return __uint_as_float((unsigned)__builtin_amdgcn_update_dpp(0, (int)__float_as_uint(v), CTRL, 0xF, 0xF, true)); }
__device__ __forceinline__ float row16_sum(float v) { v += dpp_mov<0xB1>(v); v += dpp_mov<0x4E>(v); v += dpp_mov<0x141>(v); v += dpp_mov<0x140>(v); return v; }
__device__ __forceinline__ float row16_max(float v) { v = fmaxf(v, dpp_mov<0xB1>(v)); v = fmaxf(v, dpp_mov<0x4E>(v)); v = fmaxf(v, dpp_mov<0x141>(v)); v = fmaxf(v, dpp_mov<0x140>(v)); return v; }
__device__ __forceinline__ float swap16_sum(float v) { const auto r = __builtin_amdgcn_permlane16_swap(__float_as_uint(v), __float_as_uint(v), false, false); return __uint_as_float(r[0]) + __uint_as_float(r[1]); }
__device__ __forceinline__ float swap32_sum(float v) { const auto r = __builtin_amdgcn_permlane32_swap(__float_as_uint(v), __float_as_uint(v), false, false); return __uint_as_float(r[0]) + __uint_as_float(r[1]); }
__device__ __forceinline__ float wave_sum(float v) { return swap32_sum(swap16_sum(row16_sum(v))); }
template <int CTRL> __device__ __forceinline__ unsigned dpp_shr0(unsigned v) { return (unsigned)__builtin_amdgcn_update_dpp(0, (int)v, CTRL, 0xF, 0xF, true); }
__device__ __forceinline__ unsigned wave_scan_incl(unsigned v, int lane) {
    v += dpp_shr0<0x111>(v); v += dpp_shr0<0x112>(v); v += dpp_shr0<0x114>(v); v += dpp_shr0<0x118>(v);
    const unsigned t0 = (unsigned)__builtin_amdgcn_readlane((int)v, 15), t1 = (unsigned)__builtin_amdgcn_readlane((int)v, 31), t2 = (unsigned)__builtin_amdgcn_readlane((int)v, 47);
    const int row = lane >> 4;
    return v + (row >= 1 ? t0 : 0u) + (row >= 2 ? t1 : 0u) + (row >= 3 ? t2 : 0u);
}

namespace pg8 {
typedef unsigned short bf16_t;
typedef unsigned u32x4 __attribute__((ext_vector_type(4)));
typedef unsigned u32x2 __attribute__((ext_vector_type(2)));
typedef int v4i_t __attribute__((ext_vector_type(4)));
typedef int v8i_t __attribute__((ext_vector_type(8)));
constexpr int BM = 256, BK = 64, HALF = 128, HTB = HALF * BK * 2, STAGE_BYTES = 8 * HTB, NXCD = 8, WGM = 8;
__host__ __device__ __forceinline__ int lds_byte(int r, int c16) { return (r >> 3) * 1024 + (r & 7) * 128 + ((c16 ^ (r & 6)) << 4); }
__host__ __device__ __forceinline__ void stage_rc(int b, int& R, int& C) { const int p = b >> 10, j = (b & 1023) >> 4, rr = j >> 3; R = 8 * p + rr; C = ((j & 7) ^ (rr & 6)) * 8; }
__host__ __device__ __forceinline__ int perm32(int rho) { const int n = rho >> 4, i = rho & 15; return 8 * (i >> 2) + 4 * n + (i & 3); }

struct Unit { int pm, pn, pb; };
struct Gemm { const bf16_t* A; const bf16_t* Bt; int K; const int* rows; };

struct StaticOrder {
    int nM, nN, nwg, G, c, grp;
    __device__ void init(int nM_, int nN_, int G_, int c_, int grp_) { nM = nM_; nN = nN_; nwg = nM * nN; G = G_; c = c_; grp = grp_; }
    __device__ bool next(int i, Unit& u) const {
        const long Lx = (long)i * G + c; if (Lx >= nwg) return false;
        int wgid = (int)Lx; { const int q = nwg / NXCD, r = nwg % NXCD, xcd = wgid % NXCD, off = wgid / NXCD; wgid = (xcd < r ? xcd * (q + 1) : r * (q + 1) + (xcd - r) * q) + off; }
        const int nig = WGM * nN, gid = wgid / nig, fm = gid * WGM, gsz = (nM - fm) < WGM ? (nM - fm) : WGM;
        u.pm = fm + ((wgid % nig) % gsz); u.pn = (wgid % nig) / gsz; u.pb = grp ? (u.pm / grp) * nN + u.pn : u.pn; return true;
    }
};

template <class Epi, bool GATHER, int FP8 = 0, bool PROBE_SAME = false, bool NTA = false>
__device__ __forceinline__ void gemm_phase(LAS unsigned char* lds, const Gemm g, const StaticOrder& S, const Epi& E) {
    const int tid = threadIdx.x, wid = __builtin_amdgcn_readfirstlane(tid >> 6), lane = tid & 63, wr = wid >> 2, wc = wid & 3, fr = lane & 15, fq = lane >> 4;
    const int K = g.K, nt = K / BK;
    unsigned voffA[2], voffB[2]; int stR[2], stC[2];
#pragma unroll
    for (int i = 0; i < 2; ++i) { int R, C; stage_rc(tid * 16 + i * 8192, R, C); const int Rb = Epi::PERM ? ((R & ~31) + perm32(R & 31)) : R;
        stR[i] = R; stC[i] = C; voffA[i] = (unsigned)(R * K + C) * 2u; voffB[i] = (unsigned)(Rb * K + C) * 2u; }
    const size_t kstep = (size_t)(BK * 2);
    const size_t hstep = (size_t)HALF * K * 2;
    const size_t tstep = 2 * hstep;
    const unsigned ldsw = (unsigned)wid * 1024u;
    const int aoff0 = lds_byte(wr * 64 + fr, fq), aoff1 = lds_byte(wr * 64 + fr, 4 + fq), boff0 = lds_byte(wc * 32 + fr, fq), boff1 = lds_byte(wc * 32 + fr, 4 + fq);
#define PG8_SA(b, h) (((b) * 2 + (h)) * HTB)
#define PG8_SB(b, h) ((4 + (b) * 2 + (h)) * HTB)
#define PG8_STAGE_X(bufoff, gbase, voff, AUX) do { _Pragma("unroll") for (int _i = 0; _i < 2; ++_i) \
        __builtin_amdgcn_global_load_lds((const unsigned*)((const char*)(gbase) + (voff)[_i]), (LAS unsigned*)(lds + (bufoff) + ldsw + _i * 8192), 16, 0, AUX); } while (0)
#define PG8_STAGE(bufoff, gbase, voff) PG8_STAGE_X(bufoff, gbase, voff, 0)
#define PG8_STAGE_A(b, h, kp, VO) do { if constexpr (GATHER) { PG8_STAGE(PG8_SA(b, h), (kp), VO[h]); } else if constexpr (NTA) { PG8_STAGE_X(PG8_SA(b, h), (kp) + (h) * hstep, voffA, 2); } else { PG8_STAGE(PG8_SA(b, h), (kp) + (h) * hstep, voffA); } } while (0)
#define PG8_LDA(dst, b, h) do { _Pragma("unroll") for (int m = 0; m < 4; ++m) { const v4i_t lo_ = *(const LAS v4i_t*)(lds + PG8_SA(b, h) + aoff0 + m * 2048), hi_ = *(const LAS v4i_t*)(lds + PG8_SA(b, h) + aoff1 + m * 2048); \
        dst[m] = __builtin_shufflevector(lo_, hi_, 0, 1, 2, 3, 4, 5, 6, 7); } } while (0)
#define PG8_LDB(dst, b, h) do { _Pragma("unroll") for (int n = 0; n < 2; ++n) { const v4i_t lo_ = *(const LAS v4i_t*)(lds + PG8_SB(b, h) + boff0 + n * 2048), hi_ = *(const LAS v4i_t*)(lds + PG8_SB(b, h) + boff1 + n * 2048); \
        dst[n] = __builtin_shufflevector(lo_, hi_, 0, 1, 2, 3, 4, 5, 6, 7); } } while (0)
#define PG8_LO(x) __builtin_bit_cast(bf16x8, __builtin_shufflevector(x, x, 0, 1, 2, 3))
#define PG8_HI(x) __builtin_bit_cast(bf16x8, __builtin_shufflevector(x, x, 4, 5, 6, 7))
#define PG8_MMA(ai, bj, At, Bt, Z) do { __builtin_amdgcn_s_setprio(1); if constexpr (FP8 == 3) { _Pragma("unroll") for (int m = 0; m < 4; ++m) asm volatile("" :: "v"(At[m])); \
        _Pragma("unroll") for (int n = 0; n < 2; ++n) asm volatile("" :: "v"(Bt[n])); \
        if (Z) { _Pragma("unroll") for (int m = 0; m < 4; ++m) _Pragma("unroll") for (int n = 0; n < 2; ++n) acc[ai][bj][m][n] = (f32x4){0.f, 0.f, 0.f, 0.f}; } \
        } else if constexpr (FP8) { _Pragma("unroll") for (int m = 0; m < 4; ++m) _Pragma("unroll") for (int n = 0; n < 2; ++n) \
        { if constexpr (FP8 == 2) { if (Z) acc[ai][bj][m][n] = (f32x4){0.f, 0.f, 0.f, 0.f}; \
            asm volatile("v_mfma_f32_16x16x128_f8f6f4 %0, %1, %2, %0 cbsz:2 blgp:2" : "+v"(acc[ai][bj][m][n]) : "v"(__builtin_shufflevector(Bt[n], Bt[n], 0, 1, 2, 3, 4, 5)), "v"(__builtin_shufflevector(At[m], At[m], 0, 1, 2, 3, 4, 5))); } \
          else if (Z) asm volatile("v_mfma_f32_16x16x128_f8f6f4 %0, %1, %2, 0" : "=&v"(acc[ai][bj][m][n]) : "v"(Bt[n]), "v"(At[m])); \
          else asm volatile("v_mfma_f32_16x16x128_f8f6f4 %0, %1, %2, %0" : "+v"(acc[ai][bj][m][n]) : "v"(Bt[n]), "v"(At[m])); } } else { \
        _Pragma("unroll") for (int m = 0; m < 4; ++m) _Pragma("unroll") for (int n = 0; n < 2; ++n) { \
        if (Z) acc[ai][bj][m][n] = (f32x4){0.f, 0.f, 0.f, 0.f};     \
        acc[ai][bj][m][n] = __builtin_amdgcn_mfma_f32_16x16x32_bf16(PG8_LO(Bt[n]), PG8_LO(At[m]), acc[ai][bj][m][n], 0, 0, 0); \
        acc[ai][bj][m][n] = __builtin_amdgcn_mfma_f32_16x16x32_bf16(PG8_HI(Bt[n]), PG8_HI(At[m]), acc[ai][bj][m][n], 0, 0, 0); } } __builtin_amdgcn_s_setprio(0); } while (0)
#define PG8_WAIT_V(n) asm volatile("s_waitcnt vmcnt(" #n ")" ::: "memory")
#define PG8_WAIT_L(n) asm volatile("s_waitcnt lgkmcnt(" #n ")" ::: "memory")
#define PG8_BAR __builtin_amdgcn_s_barrier()
#define PG8_SCHED __builtin_amdgcn_sched_barrier(0)
#define PG8_LOADVO(dst, un) do { _Pragma("unroll") for (int _h = 0; _h < 2; ++_h) _Pragma("unroll") for (int _i = 0; _i < 2; ++_i) { \
        const int _gr = PROBE_SAME ? stR[_i] : g.rows[(un).pm * BM + _h * HALF + stR[_i]]; dst[_h][_i] = (unsigned)(_gr * K + stC[_i]) * 2u; } } while (0)
#define PG8_LOADRAW(dst, un) do { _Pragma("unroll") for (int _h = 0; _h < 2; ++_h) _Pragma("unroll") for (int _i = 0; _i < 2; ++_i) { \
        const int* _rp = g.rows + ((un).pm * BM + _h * HALF + stR[_i]); asm volatile("global_load_dword %0, %1, off" : "=&v"(dst[_h][_i]) : "v"(_rp) : "memory"); } } while (0)
#define PG8_KITER(Z) { \
            const bool last = (t == nt - 2); \
            const char* a1 = cA + (size_t)(t + 1) * kstep; \
            const char* a2 = last ? nA : cA + (size_t)(t + 2) * kstep; const char* b2 = last ? nB : cB + (size_t)(t + 2) * kstep; \
            const char* a3 = a2 + kstep; const char* b3 = b2 + kstep; \
            unsigned v2[2][2]; \
            _Pragma("unroll") for (int h = 0; h < 2; ++h) { v2[h][0] = last ? vnxt[h][0] : vcur[h][0]; v2[h][1] = last ? vnxt[h][1] : vcur[h][1]; } \
              \
            PG8_LDB(B0, 0, 0); PG8_LDB(B1, 0, 1); PG8_SCHED; PG8_LDA(At, 0, 0); PG8_STAGE_A(1, 1, a1, vcur); \
            PG8_WAIT_V(8); PG8_WAIT_L(0); PG8_BAR; PG8_MMA(0, 0, At, B0, Z); PG8_MMA(0, 1, At, B1, Z); PG8_BAR; PG8_SCHED; \
              \
            PG8_LDA(At, 0, 1); PG8_STAGE(PG8_SB(0, 0), b2, voffB); PG8_STAGE(PG8_SB(0, 1), b2 + hstep, voffB); PG8_STAGE_A(0, 0, a2, v2); \
            PG8_WAIT_V(8); PG8_WAIT_L(0); PG8_BAR; PG8_MMA(1, 0, At, B0, Z); PG8_MMA(1, 1, At, B1, Z); PG8_BAR; PG8_SCHED; \
              \
            PG8_LDB(B0, 1, 0); PG8_LDB(B1, 1, 1); PG8_SCHED; PG8_LDA(At, 1, 0); PG8_STAGE_A(0, 1, a2, v2); \
            PG8_WAIT_V(8); PG8_WAIT_L(0); PG8_BAR; PG8_MMA(0, 0, At, B0, 0); PG8_MMA(0, 1, At, B1, 0); PG8_BAR; PG8_SCHED; \
              \
            PG8_LDA(At, 1, 1); PG8_STAGE(PG8_SB(1, 0), b3, voffB); PG8_STAGE(PG8_SB(1, 1), b3 + hstep, voffB); PG8_STAGE_A(1, 0, a3, v2); \
            PG8_WAIT_V(8); PG8_WAIT_L(0); PG8_BAR; PG8_MMA(1, 0, At, B0, 0); PG8_MMA(1, 1, At, B1, 0); PG8_BAR; PG8_SCHED; }
    Unit cur, nxt, nn; int ui = 0;
    if (!S.next(0, cur)) return;
    bool has_next = S.next(1, nxt);
    f32x4 acc[2][2][4][2];
    v8i_t At[4], B0[2], B1[2];
    unsigned vcur[2][2] = {{0u, 0u}, {0u, 0u}}, vnxt[2][2] = {{0u, 0u}, {0u, 0u}};
    if constexpr (GATHER) { PG8_LOADVO(vcur, cur); if (has_next) { PG8_LOADVO(vnxt, nxt); } else {
#pragma unroll
        for (int h = 0; h < 2; ++h) { vnxt[h][0] = vcur[h][0]; vnxt[h][1] = vcur[h][1]; } }
        PG8_WAIT_V(0); }
    const char* cA = (const char*)g.A + (GATHER ? (size_t)0 : (size_t)cur.pm * tstep); const char* cB = (const char*)g.Bt + (PROBE_SAME ? (size_t)0 : (size_t)cur.pb * tstep);
    PG8_STAGE(PG8_SB(0, 0), cB, voffB); PG8_STAGE(PG8_SB(0, 1), cB + hstep, voffB); PG8_STAGE_A(0, 0, cA, vcur); PG8_STAGE_A(0, 1, cA, vcur);
    if (wr == 1) PG8_BAR;
    PG8_WAIT_V(2); PG8_BAR;
    PG8_STAGE(PG8_SB(1, 0), cB + kstep, voffB); PG8_STAGE_A(1, 0, cA + kstep, vcur); PG8_STAGE(PG8_SB(1, 1), cB + hstep + kstep, voffB);
    PG8_WAIT_V(6); PG8_BAR;
    for (;;) {
        const char* nA = has_next ? (const char*)g.A + (GATHER ? (size_t)0 : (size_t)nxt.pm * tstep) : cA; const char* nB = has_next ? (const char*)g.Bt + (PROBE_SAME ? (size_t)0 : (size_t)nxt.pb * tstep) : cB;
        if constexpr (FP8 == 1) {
            { const int t = 0; PG8_KITER(1) }
            for (int t = 2; t < nt; t += 2) PG8_KITER(0)
        } else {
#pragma unroll
            for (int a = 0; a < 2; ++a)
#pragma unroll
                for (int b = 0; b < 2; ++b)
#pragma unroll
                    for (int m = 0; m < 4; ++m)
#pragma unroll
                        for (int n = 0; n < 2; ++n) acc[a][b][m][n] = (f32x4){0.f, 0.f, 0.f, 0.f};
            for (int t = 0; t < nt; t += 2) PG8_KITER(0)
        }
        const bool has_nn = has_next && S.next(ui + 2, nn);
        int raw[2][2];
        if constexpr (GATHER) { const Unit lu = has_nn ? nn : cur; PG8_LOADRAW(raw, lu); }
        if (wr == 0) PG8_BAR;
        if constexpr (FP8) { asm volatile("s_nop 15\n\ts_nop 15" ::: "memory"); PG8_SCHED; }
        E(acc, cur, wr, wc, fr, fq);
        if (!has_next) break;
        cur = nxt; cA = nA; cB = nB; ++ui;
#pragma unroll
        for (int h = 0; h < 2; ++h) { vcur[h][0] = vnxt[h][0]; vcur[h][1] = vnxt[h][1]; }
        if constexpr (GATHER) {
            asm volatile("s_waitcnt vmcnt(%4)" : "+v"(raw[0][0]), "+v"(raw[0][1]), "+v"(raw[1][0]), "+v"(raw[1][1]) : "n"(Epi::VM_OPS) : "memory");
            if (has_nn) {
#pragma unroll
            for (int h = 0; h < 2; ++h)
#pragma unroll
                for (int i = 0; i < 2; ++i) vnxt[h][i] = (unsigned)(raw[h][i] * K + stC[i]) * 2u; } }
        nxt = nn; has_next = has_nn;
        if (wr == 1) PG8_BAR;
    }
    PG8_WAIT_V(0);
    PG8_BAR;
#undef PG8_SA
#undef PG8_SB
#undef PG8_STAGE
#undef PG8_STAGE_X
#undef PG8_STAGE_A
#undef PG8_LDA
#undef PG8_LDB
#undef PG8_MMA
#undef PG8_LO
#undef PG8_HI
#undef PG8_LOADRAW
#undef PG8_KITER
#undef PG8_WAIT_V
#undef PG8_WAIT_L
#undef PG8_BAR
#undef PG8_SCHED
#undef PG8_LOADVO
}

struct EpiProj {
    static constexpr bool PERM = true;
    bf16_t *Q, *Kb, *V, *P; const f32x2* tab; const float *gq, *gk;
    __device__ __forceinline__ void operator()(const f32x4 (&acc)[2][2][4][2], const Unit& u, int wr, int wc, int fr, int fq) const {
        const int kind = u.pn >> 1, tcol = (u.pn & 1) * 256;
        if (kind < 2) {
            const float* gn = kind == 0 ? gq : gk; const float osc = kind == 0 ? QSCALE : 1.0f;
            f32x2 g1[4], g2[4];
#pragma unroll
            for (int q = 0; q < 4; ++q) { g1[q] = (f32x2){gn[8 * fq + 2 * q], gn[8 * fq + 2 * q + 1]} * osc; g2[q] = (f32x2){gn[32 + 8 * fq + 2 * q], gn[32 + 8 * fq + 2 * q + 1]} * osc; }
            const int rbase = u.pm * BM + wr * 64 + fr;
            f32x4 csc[4], csn[4] = {};
            { const int b0 = rbase / L, t0 = rbase - b0 * L; const f32x4* tp = (const f32x4*)(tab + (size_t)t0 * 32 + 8 * fq);
#pragma unroll
              for (int q = 0; q < 4; ++q) csc[q] = tp[q]; }
#pragma unroll
            for (int ai = 0; ai < 2; ++ai)
#pragma unroll
                for (int m = 0; m < 4; ++m) {
                    const int row = rbase + ai * HALF + m * 16; const int b = row / L, t = row - b * L;
                    if (ai * 4 + m < 7) { const int k1 = ai * 4 + m + 1, rown = rbase + (k1 >> 2) * HALF + (k1 & 3) * 16, bn = rown / L, tn = rown - bn * L;
                        const f32x4* tpn = (const f32x4*)(tab + (size_t)tn * 32 + 8 * fq);
#pragma unroll
                        for (int q = 0; q < 4; ++q) csn[q] = tpn[q]; }
                    f32x2 x1[4], x2[4];
#pragma unroll
                    for (int q = 0; q < 4; ++q) { const f32x4 a1 = acc[ai][0][m][q >> 1], a2 = acc[ai][1][m][q >> 1];
                        x1[q] = (q & 1) ? __builtin_shufflevector(a1, a1, 2, 3) : __builtin_shufflevector(a1, a1, 0, 1); x2[q] = (q & 1) ? __builtin_shufflevector(a2, a2, 2, 3) : __builtin_shufflevector(a2, a2, 0, 1); }
                    f32x2 ssp = x1[0] * x1[0];
#pragma unroll
                    for (int q = 1; q < 4; ++q) ssp = __builtin_elementwise_fma(x1[q], x1[q], ssp);
#pragma unroll
                    for (int q = 0; q < 4; ++q) ssp = __builtin_elementwise_fma(x2[q], x2[q], ssp);
                    float ss = ssp.x + ssp.y;
                    { const auto r16 = __builtin_amdgcn_permlane16_swap(__float_as_uint(ss), __float_as_uint(ss), false, false); ss = __uint_as_float(r16[0]) + __uint_as_float(r16[1]);
                      const auto r32_ = __builtin_amdgcn_permlane32_swap(__float_as_uint(ss), __float_as_uint(ss), false, false); ss = __uint_as_float(r32_[0]) + __uint_as_float(r32_[1]); }
                    const float rstd = rsqrtf(ss * (1.0f / 64.0f) + EPS);
                    f32x2 o1[4], o2[4];
#pragma unroll
                    for (int q = 0; q < 4; ++q) { const f32x4 cs = csc[q]; const f32x2 C = __builtin_shufflevector(cs, cs, 0, 1), S = __builtin_shufflevector(cs, cs, 2, 3);
                        const f32x2 y1 = x1[q] * (g1[q] * rstd), y2 = x2[q] * (g2[q] * rstd);
                        o1[q] = __builtin_elementwise_fma(-y2, S, y1 * C); o2[q] = __builtin_elementwise_fma(y1, S, y2 * C); }
                    bf16_t* dst = kind == 0 ? Q + (size_t)row * AW : Kb + ((size_t)b * LP + t) * AW;
                    dst += tcol + 64 * wc + 8 * fq;
                    u32x4 w1, w2; w1.x = pk2(o1[0].x, o1[0].y); w1.y = pk2(o1[1].x, o1[1].y); w1.z = pk2(o1[2].x, o1[2].y); w1.w = pk2(o1[3].x, o1[3].y);
                    w2.x = pk2(o2[0].x, o2[0].y); w2.y = pk2(o2[1].x, o2[1].y); w2.z = pk2(o2[2].x, o2[2].y); w2.w = pk2(o2[3].x, o2[3].y);
                    *(u32x4*)dst = w1; *(u32x4*)(dst + 32) = w2;
#pragma unroll
                    for (int q = 0; q < 4; ++q) csc[q] = csn[q];
                }
        } else {
#pragma unroll
            for (int ai = 0; ai < 2; ++ai)
#pragma unroll
                for (int m = 0; m < 4; ++m) {
                    const int row = u.pm * BM + ai * HALF + wr * 64 + m * 16 + fr; const int b = row / L, t = row - b * L;
                    bf16_t* dst = kind == 2 ? V + ((size_t)b * LP + t) * AW : P + (size_t)row * AW;
                    dst += tcol + wc * 32 + 8 * fq;
#pragma unroll
                    for (int bj = 0; bj < 2; ++bj) { const f32x4 v0 = acc[ai][bj][m][0], v1 = acc[ai][bj][m][1];
                        u32x4 w; w.x = pk2(v0[0], v0[1]); w.y = pk2(v0[2], v0[3]); w.z = pk2(v1[0], v1[1]); w.w = pk2(v1[2], v1[3]);
                        *(u32x4*)(dst + bj * HALF) = w; }
                }
        }
    }
};
struct EpiOut {
    static constexpr bool PERM = true;
    const bf16_t* XN; const float* rinv; const float* g1; bf16_t* H2;
    __device__ __forceinline__ void operator()(const f32x4 (&acc)[2][2][4][2], const Unit& u, int wr, int wc, int fr, int fq) const {
        const int col0 = u.pn * BM + wc * 32 + 8 * fq;
        float gi[2][8];
#pragma unroll
        for (int bj = 0; bj < 2; ++bj)
#pragma unroll
            for (int i = 0; i < 8; ++i) gi[bj][i] = 1.0f / g1[col0 + bj * HALF + i];
        const int rbase = u.pm * BM + wr * 64 + fr;
        u32x4 xc[2], xn[2] = {}; float ric, rin = 0.f;
        { const bf16_t* src = XN + (size_t)rbase * D; xc[0] = *(const u32x4*)(src + col0); xc[1] = *(const u32x4*)(src + col0 + HALF); ric = rinv[rbase]; }
#pragma unroll
        for (int ai = 0; ai < 2; ++ai)
#pragma unroll
            for (int m = 0; m < 4; ++m) {
                const int row = rbase + ai * HALF + m * 16; const float ri = ric;
                bf16_t* dst = H2 + (size_t)row * D;
                if (ai * 4 + m < 7) { const int k1 = ai * 4 + m + 1, rown = rbase + (k1 >> 2) * HALF + (k1 & 3) * 16; const bf16_t* src = XN + (size_t)rown * D;
                    xn[0] = *(const u32x4*)(src + col0); xn[1] = *(const u32x4*)(src + col0 + HALF); rin = rinv[rown]; }
#pragma unroll
                for (int bj = 0; bj < 2; ++bj) { const int c = col0 + bj * HALF; const u32x4 xv = xc[bj];
                    const f32x4 v0 = acc[ai][bj][m][0], v1 = acc[ai][bj][m][1];
                    u32x4 w; w.x = pk2(bf_lo(xv.x) * ri * gi[bj][0] + v0[0], bf_hi(xv.x) * ri * gi[bj][1] + v0[1]); w.y = pk2(bf_lo(xv.y) * ri * gi[bj][2] + v0[2], bf_hi(xv.y) * ri * gi[bj][3] + v0[3]);
                    w.z = pk2(bf_lo(xv.z) * ri * gi[bj][4] + v1[0], bf_hi(xv.z) * ri * gi[bj][5] + v1[1]); w.w = pk2(bf_lo(xv.w) * ri * gi[bj][6] + v1[2], bf_hi(xv.w) * ri * gi[bj][7] + v1[3]);
                    *(u32x4*)(dst + c) = w; }
                xc[0] = xn[0]; xc[1] = xn[1]; ric = rin;
            }
    }
};
struct EpiGU {
    static constexpr bool PERM = true; static constexpr int VM_OPS = 4;
    unsigned char* A2;
    __device__ __forceinline__ static u32x2 group8(const f32x4 (&acc)[2][2][4][2], int ai, int m) {
        f32x2 a[4];
#pragma unroll
        for (int i = 0; i < 4; ++i) { const f32x4 gq = acc[ai][0][m][i >> 1], uq = acc[ai][1][m][i >> 1];
            const f32x2 g2 = (i & 1) ? __builtin_shufflevector(gq, gq, 2, 3) : __builtin_shufflevector(gq, gq, 0, 1), u2 = (i & 1) ? __builtin_shufflevector(uq, uq, 2, 3) : __builtin_shufflevector(uq, uq, 0, 1);
            const f32x2 t = g2 * (-1.4426950408889634f * W8INV);
            f32x2 e; e.x = __builtin_amdgcn_exp2f(t.x); e.y = __builtin_amdgcn_exp2f(t.y);
            const f32x2 cc = {1.0f / (W8INV * W8INV), 1.0f / (W8INV * W8INV)};
            const f32x2 d = __builtin_elementwise_fma(e, cc, cc);
            f32x2 r; r.x = __builtin_amdgcn_rcpf(d.x); r.y = __builtin_amdgcn_rcpf(d.y);
            a[i] = (g2 * u2) * r; }
        u32x2 w; w.x = pk4_fp8(a[0].x, a[0].y, a[1].x, a[1].y); w.y = pk4_fp8(a[2].x, a[2].y, a[3].x, a[3].y); return w;
    }
    __device__ __forceinline__ void operator()(const f32x4 (&acc)[2][2][4][2], const Unit& u, int wr, int wc, int fr, int fq) const {
        unsigned char* const obase = A2 + (size_t)(u.pm * BM + wr * 64 + fr + (fq & 1) * 16) * FF + u.pn * HALF + wc * 32 + 16 * (fq >> 1);
#pragma unroll
        for (int ai = 0; ai < 2; ++ai)
#pragma unroll
            for (int m = 0; m < 4; m += 2) {
                const u32x2 wa = group8(acc, ai, m), wb = group8(acc, ai, m + 1);
                const auto rx = __builtin_amdgcn_permlane16_swap(wa.x, wb.x, false, false), ry = __builtin_amdgcn_permlane16_swap(wa.y, wb.y, false, false);
                u32x4 o; o.x = rx[0]; o.y = ry[0]; o.z = rx[1]; o.w = ry[1];
                *(u32x4*)(obase + (size_t)(ai * HALF + m * 16) * FF) = o;
            }
    }
};
struct EpiDown {
    static constexpr bool PERM = true;
    unsigned char* Y; const float* gate;
    __device__ __forceinline__ void operator()(const f32x4 (&acc)[2][2][4][2], const Unit& u, int wr, int wc, int fr, int fq) const {
        float gvs[2][4];
#pragma unroll
        for (int ai = 0; ai < 2; ++ai)
#pragma unroll
            for (int m = 0; m < 4; ++m) gvs[ai][m] = gate[u.pm * BM + ai * HALF + wr * 64 + m * 16 + fr];
#pragma unroll
        for (int ai = 0; ai < 2; ++ai)
#pragma unroll
            for (int m = 0; m < 4; ++m) {
                const int row = u.pm * BM + ai * HALF + wr * 64 + m * 16 + fr; const float gv = gvs[ai][m] * (W8INV * 16.0f);
                unsigned char* dst = Y + (size_t)row * D + u.pn * BM + wc * 32 + 8 * fq;
#pragma unroll
                for (int bj = 0; bj < 2; ++bj) { const f32x4 v0 = acc[ai][bj][m][0] * gv, v1 = acc[ai][bj][m][1] * gv;
                    u32x2 w; w.x = pk4_fp8(v0[0], v0[1], v0[2], v0[3]); w.y = pk4_fp8(v1[0], v1[1], v1[2], v1[3]);
                    *(u32x2*)(dst + bj * HALF) = w; }
            }
    }
};
}

namespace att {
constexpr int NW = 8, QBLK = 32, KVBLK = 64, NT = LP / KVBLK;
constexpr int LDQ = AW, LDK = AW, LDV = AW, LDO = D;
constexpr int SHM_V = KVBLK * DV * 2  , SHM_K = KVBLK * DH * 2  ;
constexpr int OFF_V = 0, OFF_K = 2 * SHM_V, OFF_WS = OFF_K + 2 * SHM_K, OFF_OST = OFF_WS + NW * 64 * 4, LDS_BYTES = OFF_OST + NW * 8192;
#define KSWZ(row, colB) ((row) * 128 + ((colB) ^ ((((row) >> 1) & 7) << 4)))
#define SBAR() __builtin_amdgcn_sched_barrier(0)
__device__ __forceinline__ int crow(int r, int hi) { return (r & 3) + 8 * (r >> 2) + 4 * hi; }
__device__ __forceinline__ int v_st(int k, int c) { const int kk = (k & ~0xC) | ((k & 4) << 1) | ((k & 8) >> 1); return ((kk >> 3) * 4 + (c >> 5)) * 512 + ((kk & 7) * 32 + (c & 31)) * 2; }
__device__ __forceinline__ int v_rd_base(int lane) { return ((lane & 3) << 3) | (((lane >> 2) & 3) << 6) | (((lane >> 4) & 1) << 5) | (((lane >> 5) & 1) << 8); }
constexpr int v_rd_off(int d0, int ks, int half) { return d0 * 512 + ks * 4096 + half * 2048; }
template <int OFF> __device__ __forceinline__ s16x4 tr_read(int vb) {
    s16x4 r; asm volatile("ds_read_b64_tr_b16 %0, %1 offset:%2" : "=&v"(r) : "v"(vb), "i"(OFF) : "memory"); return r;
}
template <int D0> __device__ __forceinline__ void pv_one(f32x16& od, int vb, bf16x8 pa0, bf16x8 pa1, bf16x8 pa2, bf16x8 pa3) {
    const s16x4 l0 = tr_read<v_rd_off(D0, 0, 0)>(vb), h0 = tr_read<v_rd_off(D0, 0, 1)>(vb), l1 = tr_read<v_rd_off(D0, 1, 0)>(vb), h1 = tr_read<v_rd_off(D0, 1, 1)>(vb);
    const s16x4 l2 = tr_read<v_rd_off(D0, 2, 0)>(vb), h2 = tr_read<v_rd_off(D0, 2, 1)>(vb), l3 = tr_read<v_rd_off(D0, 3, 0)>(vb), h3 = tr_read<v_rd_off(D0, 3, 1)>(vb);
    asm volatile("s_waitcnt lgkmcnt(0)" ::: "memory"); SBAR();
    __builtin_amdgcn_s_setprio(1);
#define PK(Lo, Hi) (bf16x8){Lo[0], Lo[1], Lo[2], Lo[3], Hi[0], Hi[1], Hi[2], Hi[3]}
    od = __builtin_amdgcn_mfma_f32_32x32x16_bf16(PK(l0, h0), pa0, od, 0, 0, 0);
    od = __builtin_amdgcn_mfma_f32_32x32x16_bf16(PK(l1, h1), pa1, od, 0, 0, 0);
    od = __builtin_amdgcn_mfma_f32_32x32x16_bf16(PK(l2, h2), pa2, od, 0, 0, 0);
    od = __builtin_amdgcn_mfma_f32_32x32x16_bf16(PK(l3, h3), pa3, od, 0, 0, 0);
    __builtin_amdgcn_s_setprio(0);
#undef PK
}
__device__ __forceinline__ void pv_tail(f32x16* o, int vb, bf16x8 pa0) {
    const s16x4 l0 = tr_read<v_rd_off(0, 0, 0)>(vb), h0 = tr_read<v_rd_off(0, 0, 1)>(vb), l1 = tr_read<v_rd_off(1, 0, 0)>(vb), h1 = tr_read<v_rd_off(1, 0, 1)>(vb);
    const s16x4 l2 = tr_read<v_rd_off(2, 0, 0)>(vb), h2 = tr_read<v_rd_off(2, 0, 1)>(vb), l3 = tr_read<v_rd_off(3, 0, 0)>(vb), h3 = tr_read<v_rd_off(3, 0, 1)>(vb);
    asm volatile("s_waitcnt lgkmcnt(0)" ::: "memory"); SBAR();
#define PK(Lo, Hi) (bf16x8){Lo[0], Lo[1], Lo[2], Lo[3], Hi[0], Hi[1], Hi[2], Hi[3]}
    o[0] = __builtin_amdgcn_mfma_f32_32x32x16_bf16(PK(l0, h0), pa0, o[0], 0, 0, 0);
    o[1] = __builtin_amdgcn_mfma_f32_32x32x16_bf16(PK(l1, h1), pa0, o[1], 0, 0, 0);
    o[2] = __builtin_amdgcn_mfma_f32_32x32x16_bf16(PK(l2, h2), pa0, o[2], 0, 0, 0);
    o[3] = __builtin_amdgcn_mfma_f32_32x32x16_bf16(PK(l3, h3), pa0, o[3], 0, 0, 0);
#undef PK
}
__device__ __forceinline__ void pv_d0(f32x16* o, int vb, bf16x8 pa0, bf16x8 pa1, bf16x8 pa2, bf16x8 pa3) {
    pv_one<0>(o[0], vb, pa0, pa1, pa2, pa3); pv_one<1>(o[1], vb, pa0, pa1, pa2, pa3); pv_one<2>(o[2], vb, pa0, pa1, pa2, pa3); pv_one<3>(o[3], vb, pa0, pa1, pa2, pa3);
}
__device__ __forceinline__ void qkt(f32x16& p0, f32x16& p1, const LAS char* Ks, const bf16x8* qr, int r32, int hi) {
    p0 = f32x16{}; p1 = f32x16{};
#pragma unroll
    for (int d0 = 0; d0 < 4; ++d0) { const int cb = d0 * 32 + hi * 16;
        const bf16x8 b0 = *(const LAS bf16x8*)(Ks + KSWZ(r32, cb));
        const bf16x8 b1 = *(const LAS bf16x8*)(Ks + KSWZ(32 + r32, cb));
        p0 = __builtin_amdgcn_mfma_f32_32x32x16_bf16(b0, qr[d0], p0, 0, 0, 0);
        p1 = __builtin_amdgcn_mfma_f32_32x32x16_bf16(b1, qr[d0], p1, 0, 0, 0); }
}
__device__ __forceinline__ void partialSM(f32x16& p0) {
#pragma unroll
    for (int r = 0; r < 16; ++r) p0[r] = __builtin_amdgcn_exp2f(p0[r]);
}
template <bool MASK> __device__ __forceinline__ void finishSM(f32x16& p0, f32x16& p1, float& l_reg, bf16x8& pa0, bf16x8& pa1, bf16x8& pa2, bf16x8& pa3) {
    if constexpr (MASK) {
#pragma unroll
        for (int r = 8; r < 16; ++r) p0[r] = 0.f;
#pragma unroll
        for (int r = 0; r < 16; ++r) p1[r] = 0.f;
    } else {
#pragma unroll
        for (int r = 0; r < 16; ++r) p1[r] = __builtin_amdgcn_exp2f(p1[r]);
    }
    float ps = 0.f;
#pragma unroll
    for (int r = 0; r < 16; ++r) ps += p0[r];
#pragma unroll
    for (int r = 0; r < 16; ++r) ps += p1[r];
    l_reg += ps;
#define PK4(P, BASE, OUT) do { v4u w = {pk2(P[BASE + 0], P[BASE + 1]), pk2(P[BASE + 2], P[BASE + 3]), pk2(P[BASE + 4], P[BASE + 5]), pk2(P[BASE + 6], P[BASE + 7])}; \
    OUT = __builtin_bit_cast(bf16x8, w); } while (0)
    PK4(p0, 0, pa0); PK4(p0, 8, pa1); PK4(p1, 0, pa2); PK4(p1, 8, pa3);
#undef PK4
}

constexpr int KSLOT = SHM_K, VSLOT = SHM_V, OFF_KR = 0, OFF_VR = 3 * KSLOT, OFF_WS2 = OFF_VR + 4 * VSLOT, OFF_ST = OFF_WS2 + NW * 64 * 4, LDS_BYTES2 = OFF_ST + NW * 8192;
#define WAIT_BAR(N) asm volatile("s_waitcnt vmcnt(" #N ") lgkmcnt(0)\n\ts_barrier" ::: "memory")
struct MixArgs { bf16* MIX; const bf16* P; const float* subg; float lam; int b, h, q0; };
template <int MODE>
__device__ __forceinline__ void attn_unit(const bf16* __restrict__ Qb, const bf16* __restrict__ Kg, const bf16* __restrict__ Vg, bf16* __restrict__ Ob, int ldo, int nrows, const MixArgs ma, LAS char* lds, bool pre_in = false, bool pre_out = false) {
    int tid_ = threadIdx.x; asm volatile("" : "+v"(tid_));
    const int tid = tid_, wid = __builtin_amdgcn_readfirstlane(tid >> 6), lane = tid & 63, r32 = lane & 31, hi = lane >> 5;
    LAS char* K_lds = lds + OFF_KR; LAS char* V_lds = lds + OFF_VR;
    LAS float* wsf = (LAS float*)(lds + OFF_WS2) + wid * 64;
    LAS bf16* stg = (LAS bf16*)(lds + wid * 8192);
    const bool active = wid * QBLK < nrows;
    int qrow = wid * QBLK + r32; qrow = qrow < nrows ? qrow : nrows - 1;
    const char* Qc = (const char*)Qb; char* Oc = (char*)Ob;
    const unsigned qo = (unsigned)(qrow * LDQ + hi * 8) * 2u;
    const int krow = 8 * wid + (lane >> 3);
    const unsigned ksrc = (unsigned)(krow * LDK + (((lane & 7) ^ ((krow >> 1) & 7)) * 8)) * 2u;
    unsigned vsrc[2];
#pragma unroll
    for (int i = 0; i < 2; ++i) { const int p = wid + 8 * i, s = 2 * p + (lane >> 5), kk = (s >> 2) * 8 + ((lane & 31) >> 2), k = kk  , c = (s & 3) * 32 + (lane & 3) * 8;
        vsrc[i] = (unsigned)(k * LDV + c) * 2u; }
    const char* Vc = (const char*)Vg;
    const int vb0 = (int)(unsigned)(uintptr_t)V_lds + v_rd_base(lane);
    LAS bf16* stash = (LAS bf16*)(lds + OFF_ST + wid * 8192);
#pragma unroll 1
    for (int mp = 0; mp < (MODE ? 2 : 1); ++mp) {
    const char* Kc = (const char*)Kg + mp * (DH * 2);
    float l_reg = 0.f; f32x16 o[4] = {}; bf16x8 qr[4];
#pragma unroll
    for (int d0 = 0; d0 < 4; ++d0) qr[d0] = *(const bf16x8*)(Qc + qo + mp * (DH * 2) + d0 * 32);
#define DMA_TILE(t, ks, vs) DMA_TILE_K(Kc, t, ks, vs)
#define DMA_TILE_K(KC, t, ks, vs) do { const char* kt_ = (KC) + (size_t)(t) * (KVBLK * LDK * 2); const char* vt_ = Vc + (size_t)(t) * (KVBLK * LDV * 2); \
    __builtin_amdgcn_global_load_lds((const unsigned*)(kt_ + ksrc), (LAS unsigned*)(K_lds + (ks) + wid * 1024), 16, 0, 0); \
    __builtin_amdgcn_global_load_lds((const unsigned*)(vt_ + vsrc[0]), (LAS unsigned*)(V_lds + (vs) + wid * 1024), 16, 0, 0); \
    __builtin_amdgcn_global_load_lds((const unsigned*)(vt_ + vsrc[1]), (LAS unsigned*)(V_lds + (vs) + (wid + 8) * 1024), 16, 0, 0); } while (0)
    f32x16 pA0, pA1, pB0, pB1; bf16x8 pa0, pa1, pa2, pa3;
    int ks_c = 0, vs_c = 0;
    int vs_p = 0;
    int ks_n2 = 2 * KSLOT, vs_n2 = 2 * VSLOT;
#define ROT() do { vs_p = vs_c; ks_c = (ks_c == 2 * KSLOT) ? 0 : ks_c + KSLOT; vs_c = (vs_c == 3 * VSLOT) ? 0 : vs_c + VSLOT; \
    ks_n2 = (ks_n2 == 2 * KSLOT) ? 0 : ks_n2 + KSLOT; vs_n2 = (vs_n2 == 3 * VSLOT) ? 0 : vs_n2 + VSLOT; } while (0)
    if (!(MODE == 1 && (mp == 1 || pre_in))) { DMA_TILE(0, 0, 0); DMA_TILE(1, KSLOT, VSLOT); }
    WAIT_BAR(3);
    if (active) { qkt(pA0, pA1, K_lds, qr, r32, hi); partialSM(pA0); }
    DMA_TILE(2, 2 * KSLOT, 2 * VSLOT);
    WAIT_BAR(5);
    ROT();
#pragma unroll 1
    for (int j = 1; j + 1 < NT; j += 2) {
        if (j + 2 < NT) DMA_TILE(j + 2, ks_n2, vs_n2);
        if (active) {
            SBAR(); qkt(pB0, pB1, K_lds + ks_c, qr, r32, hi);
            finishSM<false>(pA0, pA1, l_reg, pa0, pa1, pa2, pa3); SBAR();
            pv_d0(o, vb0 + vs_p, pa0, pa1, pa2, pa3); partialSM(pB0);
        }
        if (j + 2 < NT) WAIT_BAR(5); else WAIT_BAR(0);
        ROT();
        if (j + 3 < NT) DMA_TILE(j + 3, ks_n2, vs_n2);
        if (active) {
            SBAR(); qkt(pA0, pA1, K_lds + ks_c, qr, r32, hi);
            finishSM<false>(pB0, pB1, l_reg, pa0, pa1, pa2, pa3); SBAR();
            pv_d0(o, vb0 + vs_p, pa0, pa1, pa2, pa3); partialSM(pA0);
        }
        if (j + 3 < NT) WAIT_BAR(5); else WAIT_BAR(0);
        ROT();
    }
    if (active) {
        finishSM<true>(pA0, pA1, l_reg, pa0, pa1, pa2, pa3); SBAR();
        pv_tail(o, vb0 + vs_p, pa0);
    }
    WAIT_BAR(0);
    if (MODE == 1 && mp == 0) { const char* Kc1 = (const char*)Kg + (DH * 2);
        DMA_TILE_K(Kc1, 0, 0, 0); DMA_TILE_K(Kc1, 1, KSLOT, VSLOT); }
    int lane2 = lane; asm volatile("" : "+v"(lane2));
    const int r32e = lane2 & 31, hie = lane2 >> 5;
    if (active) {
        { auto rr = __builtin_amdgcn_permlane32_swap(__float_as_uint(l_reg), __float_as_uint(l_reg), false, false); l_reg = __uint_as_float(rr[0]) + __uint_as_float(rr[1]); }
        const float rl = 1.0f / l_reg;
        LAS char* sbase = (LAS char*)((MODE == 1 && mp == 0) ? (LAS char*)stash : (LAS char*)stg) + r32e * 256;
        LAS char* rbase = (LAS char*)stash + r32e * 256;
#pragma unroll
        for (int d0 = 0; d0 < 4; ++d0)
#pragma unroll
            for (int g4 = 0; g4 < 4; ++g4) { const int dv0 = 32 * d0 + 8 * g4 + 4 * hie; const int off = ((((dv0 >> 3) ^ (r32e & 15))) << 4) + (dv0 & 7) * 2;
                float v[4];
#pragma unroll
                for (int j = 0; j < 4; ++j) v[j] = o[d0][4 * g4 + j] * rl;
                if (MODE == 1 && mp == 1) { const pg8::u32x2 s2 = *(const LAS pg8::u32x2*)(rbase + off);
                    v[0] = bf_lo(s2.x) - ma.lam * v[0]; v[1] = bf_hi(s2.x) - ma.lam * v[1]; v[2] = bf_lo(s2.y) - ma.lam * v[2]; v[3] = bf_hi(s2.y) - ma.lam * v[3]; }
                pg8::u32x2 w2; w2.x = pk2(v[0], v[1]); w2.y = pk2(v[2], v[3]);
                *(LAS pg8::u32x2*)(sbase + off) = w2; }
        asm volatile("s_waitcnt lgkmcnt(0)" ::: "memory");
        if (!(MODE == 1 && mp == 0)) {
            const int ch = lane2 & 15;
            if (MODE == 0) {
#pragma unroll
                for (int i = 0; i < 8; ++i) { const int row = i * 4 + (lane2 >> 4); const v4u v = *(const LAS v4u*)((LAS char*)stg + row * 256 + ((ch ^ (row & 15)) << 4));
                    if (wid * QBLK + row < nrows) *(v4u*)(Oc + (unsigned)((wid * QBLK + row) * ldo + ch * 8) * 2u) = v; }
            } else {
                float sg[8];
#pragma unroll
                for (int i = 0; i < 8; ++i) sg[i] = ma.subg[8 * ch + i] * (1.0f - LAM_INIT);
                bf16* mrow = ma.MIX + ((size_t)ma.b * L + ma.q0 + wid * QBLK) * D + ma.h * DV + ch * 8;
#pragma unroll
                for (int i = 0; i < 8; ++i) { const int row = i * 4 + (lane2 >> 4); const v4u v = *(const LAS v4u*)((LAS char*)stg + row * 256 + ((ch ^ (row & 15)) << 4));
                    float x[8]; float ss = 0.f;
#pragma unroll
                    for (int q = 0; q < 4; ++q) { x[2 * q] = bf_lo(v[q]); x[2 * q + 1] = bf_hi(v[q]); ss += x[2 * q] * x[2 * q] + x[2 * q + 1] * x[2 * q + 1]; }
                    ss = row16_sum(ss);
                    const float rstd = rsqrtf(ss * (1.0f / DV) + EPS);
                    v4u w;
#pragma unroll
                    for (int q = 0; q < 4; ++q) w[q] = pk2(x[2 * q] * rstd * sg[2 * q], x[2 * q + 1] * rstd * sg[2 * q + 1]);
                    *(v4u*)(mrow + (size_t)row * D) = w; }
            }
        }
    }
    WAIT_BAR(0);
#undef DMA_TILE
#undef ROT
    }
    if (MODE == 1) {
        if (pre_out) { const char* Kc0 = (const char*)Kg;
            DMA_TILE_K(Kc0, 0, 0, 0); DMA_TILE_K(Kc0, 1, KSLOT, VSLOT); }
#undef DMA_TILE_K
        int tid3 = threadIdx.x; asm volatile("" : "+v"(tid3)); const int tid = tid3, lane = tid3 & 63;
        constexpr int SLAB_OFF = 86 * 1024;
        const int w2 = 1 << ma.h; const bf16* Pb = ma.P + (size_t)ma.b * L * AW + ma.h * 128;
        { v4u tmp[9];
#pragma unroll
          for (int q = 0; q < 9; ++q) { const int i = tid + q * 512; int t = ma.q0 - 8 + (i >> 4); t = t < 0 ? 0 : (t >= L ? L - 1 : t); tmp[q] = *(const v4u*)(Pb + (size_t)t * AW + (i & 15) * 8); }
#pragma unroll
          for (int q = 0; q < 9; ++q) { const int i = tid + q * 512; if (i < 272 * 16) *(LAS v4u*)(lds + SLAB_OFF + (i >> 4) * 256 + (i & 15) * 16) = tmp[q]; } }
        asm volatile("s_waitcnt lgkmcnt(0)\n\ts_barrier" ::: "memory");
        const int ch = lane & 15;
        bf16* mrow = ma.MIX + ((size_t)ma.b * L + ma.q0 + wid * QBLK) * D + 512 + ma.h * 128 + ch * 8;
        { const int row0 = wid * QBLK + (lane >> 4) * 8, t00 = ma.q0 + row0;
          float S[8];
#pragma unroll
          for (int q = 0; q < 8; ++q) S[q] = 0.f;
          const LAS char* sb0 = lds + SLAB_OFF + (row0 + 8) * 256 + ch * 16;
#define POOL_ADD(U, SGN) do { const int u_ = (U); if (u_ >= 0 && u_ < L) { const v4u pv_ = *(const LAS v4u*)(sb0 + (u_ - t00) * 256); \
              _Pragma("unroll") for (int q = 0; q < 4; ++q) { S[2 * q] += (SGN) * bf_lo(pv_[q]); S[2 * q + 1] += (SGN) * bf_hi(pv_[q]); } } } while (0)
          for (int k = -w2; k < w2; ++k) POOL_ADD(t00 + k, 1.0f);
#pragma unroll 1
          for (int i = 0; i < 8; ++i) { const int t = t00 + i;
              if (i) { POOL_ADD(t + w2 - 1, 1.0f); POOL_ADD(t - 1 - w2, -1.0f); }
              const int lo = (t - w2) > 0 ? (t - w2) : 0, hi2 = (t + w2) < L ? (t + w2) : L;
              const float inv = 1.0f / (float)(hi2 - lo);
              const v4u pt = *(const LAS v4u*)(sb0 + i * 256);
              v4u wp;
#pragma unroll
              for (int q = 0; q < 4; ++q) wp[q] = pk2(S[2 * q] * inv - bf_lo(pt[q]), S[2 * q + 1] * inv - bf_hi(pt[q]));
              *(v4u*)(mrow + (size_t)((lane >> 4) * 8 + i) * D) = wp; }
#undef POOL_ADD
        }
        WAIT_BAR(0);
    }
}

__device__ __forceinline__ void attn_rem_unit(const bf16* __restrict__ Qb, const bf16* __restrict__ Kg, const bf16* __restrict__ Vg, bf16* __restrict__ Ob, int nrows, LAS char* lds) {
    int tid_ = threadIdx.x; asm volatile("" : "+v"(tid_));
    const int tid = tid_, wid = __builtin_amdgcn_readfirstlane(tid >> 6), lane = tid & 63, r32 = lane & 31, hi = lane >> 5;
    LAS char* slot = lds + wid * 16384;
    LAS float* lpart = (LAS float*)(lds + 131072);
    LAS unsigned short* ostage = (LAS unsigned short*)(lds + 131072 + 1024);
    const int qrow = r32 < nrows ? r32 : nrows - 1;
    const char* Qc = (const char*)Qb + (unsigned)(qrow * LDQ + hi * 8) * 2u;
    bf16x8 qr[4];
#pragma unroll
    for (int d0 = 0; d0 < 4; ++d0) qr[d0] = *(const bf16x8*)(Qc + d0 * 32);
    const int vb = (int)(unsigned)(uintptr_t)slot + v_rd_base(lane);
    f32x16 o[4] = {}; float l_reg = 0.f;
#pragma unroll 1
    for (int t = wid; t < NT; t += NW) {
        const char* vt = (const char*)Vg + (size_t)t * (KVBLK * LDV * 2);
#pragma unroll
        for (int p = 0; p < 16; ++p) { const int s = 2 * p + (lane >> 5), kk = (s >> 2) * 8 + ((lane & 31) >> 2), c = (s & 3) * 32 + (lane & 3) * 8;
            __builtin_amdgcn_global_load_lds((const unsigned*)(vt + (unsigned)(kk * LDV + c) * 2u), (LAS unsigned*)(slot + p * 1024), 16, 0, 0); }
        const char* kt = (const char*)Kg + (size_t)t * (KVBLK * LDK * 2) + (unsigned)(r32 * LDK) * 2u + hi * 16;
        bf16x8 b0[4], b1[4];
#pragma unroll
        for (int d0 = 0; d0 < 4; ++d0) { b0[d0] = *(const bf16x8*)(kt + d0 * 32); b1[d0] = *(const bf16x8*)(kt + 32 * LDK * 2 + d0 * 32); }
        f32x16 p0 = {}, p1 = {};
#pragma unroll
        for (int d0 = 0; d0 < 4; ++d0) { p0 = __builtin_amdgcn_mfma_f32_32x32x16_bf16(b0[d0], qr[d0], p0, 0, 0, 0); p1 = __builtin_amdgcn_mfma_f32_32x32x16_bf16(b1[d0], qr[d0], p1, 0, 0, 0); }
        partialSM(p0);
        bf16x8 pa0, pa1, pa2, pa3;
        asm volatile("s_waitcnt vmcnt(0)" ::: "memory");
        if (t == NT - 1) { finishSM<true>(p0, p1, l_reg, pa0, pa1, pa2, pa3); SBAR(); pv_tail(o, vb, pa0); }
        else { finishSM<false>(p0, p1, l_reg, pa0, pa1, pa2, pa3); SBAR(); pv_d0(o, vb, pa0, pa1, pa2, pa3); }
        asm volatile("s_waitcnt lgkmcnt(0)" ::: "memory");
    }
    { auto rr = __builtin_amdgcn_permlane32_swap(__float_as_uint(l_reg), __float_as_uint(l_reg), false, false); l_reg = __uint_as_float(rr[0]) + __uint_as_float(rr[1]); }
#pragma unroll
    for (int d0 = 0; d0 < 4; ++d0)
#pragma unroll
        for (int r = 0; r < 16; ++r) *(LAS float*)(slot + ((d0 * 16 + r) * 64 + lane) * 4) = o[d0][r];
    if (hi == 0) lpart[wid * 32 + r32] = l_reg;
    asm volatile("s_waitcnt lgkmcnt(0)\n\ts_barrier" ::: "memory");
    { float lt = 0.f;
#pragma unroll
      for (int w = 0; w < NW; ++w) lt += lpart[w * 32 + r32];
      const float rl = 1.0f / lt; const int d0 = wid >> 1;
#pragma unroll
      for (int i = 0; i < 8; ++i) { const int r = 8 * (wid & 1) + i; float sum = 0.f;
#pragma unroll
          for (int w = 0; w < NW; ++w) sum += *(const LAS float*)(lds + w * 16384 + ((d0 * 16 + r) * 64 + lane) * 4);
          const int dv = 32 * d0 + (r & 3) + 8 * (r >> 2) + 4 * hi;
          if (r32 < 16) ostage[r32 * DV + dv] = (unsigned short)(pk2(sum * rl, 0.f) & 0xffffu); } }
    asm volatile("s_waitcnt lgkmcnt(0)\n\ts_barrier" ::: "memory");
    if (wid == 0) {
#pragma unroll
        for (int i = 0; i < 4; ++i) { const int ch = i * 64 + lane; const v4u v = *(const LAS v4u*)((LAS char*)ostage + ch * 16);
            if ((ch >> 4) < nrows) *(v4u*)((char*)Ob + ch * 16) = v; }
    }
    asm volatile("s_waitcnt lgkmcnt(0)\n\ts_barrier" ::: "memory");
}
#undef WAIT_BAR
#undef KSWZ
#undef SBAR
}

constexpr size_t MiB = 1u << 20;
constexpr size_t WS_CTL = 0, CTL_ZERO_BYTES = 64 * 1024;
constexpr size_t WS_TAB = 1 * MiB;
constexpr size_t WS_AFF = 2 * MiB;
constexpr size_t WS_SLOT = 7 * MiB;
constexpr size_t WS_ROWIDX = 12 * MiB, WS_ROWGATE = 13 * MiB;
constexpr size_t WS_RINV = 14 * MiB;
constexpr size_t WS_WIN = 16 * MiB, WS_WOUT = 20 * MiB;
constexpr size_t WS_WD = 24 * MiB, WS_WGU = 88 * MiB;
constexpr size_t WS_XN = 216 * MiB;
constexpr size_t WS_BIG = 352 * MiB;
constexpr size_t WS_Q = WS_BIG, WS_K = WS_BIG + 65 * MiB, WS_V = WS_BIG + 131 * MiB, WS_P = WS_BIG + 197 * MiB, WS_OA = WS_BIG + 262 * MiB, WS_MIX = WS_BIG + 392 * MiB;
constexpr size_t WS_A2 = WS_BIG;
constexpr size_t WS_Y = 88 * MiB;
constexpr size_t WS_H2 = WS_A2 + (size_t)MT * FF * 2;
constexpr size_t WS_END = WS_H2 + (size_t)M * D * 2;
static_assert(WS_Y + (size_t)MT * D * 2 <= WS_BIG && WS_XN + (size_t)M * D * 2 <= WS_BIG && WS_MIX + (size_t)M * D * 2 <= WS_H2 && WS_END <= 1024 * MiB, "d_ws map");
static_assert(WS_K + (size_t)BATCH * LP * AW * 2 <= WS_V && WS_V + (size_t)BATCH * LP * AW * 2 <= WS_P && WS_P + (size_t)M * AW * 2 <= WS_OA && WS_OA + (size_t)M * D * 2 <= WS_MIX, "d_ws map 2");
constexpr int CW_BAR = 4096, CW_PAIR = 8192;

constexpr int RING_BYTES = 131072, LDSCTL_OFF = 159744, MISC_OFF = LDSCTL_OFF + 320, LDS_BYTES = 163840;
constexpr int NWAVES = 8, NPHASE = 10;

#define XB_TMO      128
#define XB_XCNT(j)  (256  + 64 * (j))
#define XB_XSUB(j)  (1280 + 64 * (j))
#define XB_XGEN(j)  (2304 + 64 * (j))
#define XB_TOP      3328
#define XB_TOPGEN   3392
#define XCD_BAR_WORDS 3456
#define XB_SPIN_CAP (1u << 22)
__device__ __forceinline__ unsigned xb_ld(unsigned* p)              { return __hip_atomic_load(p, __ATOMIC_RELAXED, __HIP_MEMORY_SCOPE_AGENT); }
__device__ __forceinline__ unsigned xb_add(unsigned* p, unsigned v) { return __hip_atomic_fetch_add(p, v, __ATOMIC_RELAXED, __HIP_MEMORY_SCOPE_AGENT); }
__device__ __forceinline__ unsigned xb_xcc_id() { return (unsigned)__builtin_amdgcn_s_getreg((3 << 11) | 20) & 0xFu; }
#define XB_SPIN(cond, bar) do { unsigned _sp = 0; while (cond) { __builtin_amdgcn_s_sleep(1); \
    if ((++_sp & 255u) == 0u) { if (xb_ld(&(bar)[XB_TMO])) break; if (_sp > XB_SPIN_CAP) { atomicAdd(&(bar)[XB_TMO], 1u); break; } } } } while (0)
struct XcdBarrier { unsigned* bar; unsigned x; volatile LAS unsigned* st; };
__device__ __forceinline__ XcdBarrier xcd_barrier_post(unsigned* bar, volatile LAS unsigned* st) {
    XcdBarrier b; b.bar = bar; b.x = xb_xcc_id(); b.st = st;
    if (threadIdx.x == 0) (void)xb_add(&bar[XB_XCNT(b.x)], 1u);
    return b;
}
__device__ __forceinline__ void xcd_barrier_complete(unsigned* bar, unsigned x, unsigned& nloc, unsigned& nx) {
    const unsigned G = gridDim.x * gridDim.y * gridDim.z;
    unsigned sum, cnt, mine, sp = 0u;
    for (;;) {
        sum = 0u; cnt = 0u; mine = 0u;
#pragma unroll
        for (unsigned j = 0; j < 16; ++j) { const unsigned c = xb_ld(&bar[XB_XCNT(j)]); sum += c; cnt += (c > 0u) ? 1u : 0u; mine = (j == x) ? c : mine; }
        if (sum == G) break;
        __builtin_amdgcn_s_sleep(1);
        if ((++sp & 255u) == 0u) { if (xb_ld(&bar[XB_TMO])) break; if (sp > XB_SPIN_CAP) { atomicAdd(&bar[XB_TMO], 1u); break; } }
    }
    nloc = mine > 0u ? mine : 1u; nx = cnt > 0u ? cnt : 1u;
}
__device__ __forceinline__ void xcd_barrier(const XcdBarrier& b) {
    asm volatile("s_waitcnt vmcnt(0)" ::: "memory");
    __syncthreads();
    if (threadIdx.x == 0) {
        unsigned* bar = b.bar;
        __builtin_amdgcn_s_waitcnt(0);
        unsigned nloc = b.st[0], nx = b.st[1];
        if (nloc == 0u) { xcd_barrier_complete(bar, b.x, nloc, nx); b.st[0] = nloc; b.st[1] = nx; }
        const unsigned old = xb_add(&bar[XB_XSUB(b.x)], 1u);
        const unsigned gen = old / nloc;
        if (old + 1u == (gen + 1u) * nloc) {
            __builtin_amdgcn_fence(__ATOMIC_RELEASE, "agent");
            asm volatile("s_waitcnt vmcnt(0)" ::: "memory");
            const unsigned og = xb_add(&bar[XB_TOP], 1u);
            const unsigned tg = og / nx;
            if (og + 1u == (tg + 1u) * nx) xb_add(&bar[XB_TOPGEN], 1u);
            else XB_SPIN(xb_ld(&bar[XB_TOPGEN]) == tg, bar);
            __builtin_amdgcn_fence(__ATOMIC_ACQUIRE, "agent");
            xb_add(&bar[XB_XGEN(b.x)], 1u);
            asm volatile("s_waitcnt vmcnt(0)" ::: "memory");
        } else {
            XB_SPIN(xb_ld(&bar[XB_XGEN(b.x)]) == gen, bar);
            __builtin_amdgcn_fence(__ATOMIC_ACQUIRE, "agent");
            asm volatile("s_waitcnt vmcnt(0)" ::: "memory");
        }
    }
    __syncthreads();
}

struct Frame {
    LAS unsigned char* lds;
    volatile LAS unsigned* MISC;
    int tid, lane, wave, vcu, G;
    const float *x, *meta, *ln1g, *w_in, *qng, *kng, *lq1, *lk1, *lq2, *lk2, *subg, *poolw, *pools, *w_out, *ln2g, *w_router, *w_gate, *w_up, *w_down;
    float* out; unsigned char* ws;
};

template <class RowMap>
__device__ __forceinline__ void p0_transpose_item(const float* W, int N, bf16* WT, int ldd, int k0, int n0, RowMap rm, LAS float* scr, int lane) {
    { float rv[32]; const float* wp = W + (size_t)(k0 + (lane >> 5)) * N + n0 + (lane & 31);
#pragma unroll
      for (int i = 0; i < 32; ++i) rv[i] = __builtin_nontemporal_load(wp + (size_t)(2 * i) * N);
#pragma unroll
      for (int i = 0; i < 32; ++i) scr[(2 * i + (lane >> 5)) * 33 + (lane & 31)] = rv[i]; }
    LDS_WAIT(); asm volatile("" ::: "memory");
    const int c = lane & 7;
#pragma unroll
    for (int j = 0; j < 4; ++j) { const int n = (lane >> 3) + 8 * j; const LAS float* s = scr + (8 * c) * 33 + n;
        v4u o; o.x = pk2(s[0 * 33], s[1 * 33]); o.y = pk2(s[2 * 33], s[3 * 33]); o.z = pk2(s[4 * 33], s[5 * 33]); o.w = pk2(s[6 * 33], s[7 * 33]);
        *(v4u*)(WT + (size_t)rm(n0 + n) * ldd + k0 + 8 * c) = o; }
    LDS_WAIT(); asm volatile("" ::: "memory");
}
template <class RowMap>
__device__ __forceinline__ void p0_transpose_item8(const float* W, int N, unsigned char* WT8, int ldd, int k0, int n0, RowMap rm, LAS float* scr, int lane) {
    { float rv[32]; const float* wp = W + (size_t)(k0 + (lane >> 5)) * N + n0 + (lane & 31);
#pragma unroll
      for (int i = 0; i < 32; ++i) rv[i] = __builtin_nontemporal_load(wp + (size_t)(2 * i) * N);
#pragma unroll
      for (int i = 0; i < 32; ++i) scr[(2 * i + (lane >> 5)) * 33 + (lane & 31)] = rv[i]; }
    LDS_WAIT(); asm volatile("" ::: "memory");
    const int n = lane >> 1, kh = (lane & 1) * 32; const LAS float* s = scr + kh * 33 + n;
    unsigned char* dst = WT8 + (size_t)rm(n0 + n) * ldd + k0 + kh;
#pragma unroll
    for (int q = 0; q < 2; ++q) { v4u o;
#pragma unroll
        for (int d = 0; d < 4; ++d) { const LAS float* p = s + (q * 16 + d * 4) * 33; o[d] = pk4_fp8(p[0] * W8SCALE, p[33] * W8SCALE, p[66] * W8SCALE, p[99] * W8SCALE); }
        *(v4u*)(dst + q * 16) = o; }
    LDS_WAIT(); asm volatile("" ::: "memory");
}
struct RmIn { __device__ __forceinline__ int operator()(int n) const { if (n >= 1024) return n; const int w = n & 255; return (n & ~255) + (((w >> 5) & 1) << 7) + ((w >> 6) << 5) + (w & 31); } };
struct RmId { __device__ __forceinline__ int operator()(int n) const { return n; } };
struct RmGU { int half; __device__ __forceinline__ int operator()(int f) const { return ((f >> 7) << 8) + (half << 7) + (f & 127); } };

constexpr int MOE_IG = (D / 64) * (FF / 32), MOE_ID = (FF / 64) * (D / 32), MOE_PER = 2 * MOE_IG + MOE_ID, MOE_ITEMS = NE * MOE_PER;
constexpr int MOE_P0 = 12288, MOE_F1 = 30720;
struct MoeItem { const float* wp; size_t n; unsigned char* dst; };
__device__ __forceinline__ MoeItem moe_item_ref(const Frame& F, int it, int lane) {
    unsigned char* Wgu_t = F.ws + WS_WGU; unsigned char* Wd_t = F.ws + WS_WD;
    const int e = it / MOE_PER; int r = it - e * MOE_PER;
    const float* W; int N, ldd, k0, n0, row; unsigned char* WT8;
    const int nl = lane >> 1;
    if (r < 2 * MOE_IG) { const int half = r >= MOE_IG; r -= half * MOE_IG; const int nb = FF / 32; W = (half ? F.w_up : F.w_gate) + (size_t)e * D * FF; N = FF; WT8 = Wgu_t + (size_t)e * 2 * FF * D; ldd = D;
        k0 = 64 * (r / nb); n0 = 32 * (r % nb); row = RmGU{half}(n0 + nl); }
    else { r -= 2 * MOE_IG; const int nb = D / 32; W = F.w_down + (size_t)e * FF * D; N = D; WT8 = Wd_t + (size_t)e * D * FF; ldd = FF; k0 = 64 * (r / nb); n0 = 32 * (r % nb); row = n0 + nl; }
    MoeItem m; m.wp = W + (size_t)(k0 + (lane >> 5)) * N + n0 + (lane & 31); m.n = (size_t)N; m.dst = WT8 + (size_t)row * ldd + k0 + (lane & 1) * 32; return m;
}
__device__ __forceinline__ void moe_item_load(const MoeItem& m, float (&rv)[32]) {
#pragma unroll
    for (int i = 0; i < 32; ++i) rv[i] = __builtin_nontemporal_load(m.wp + (size_t)(2 * i) * m.n);
}
__device__ __forceinline__ void moe_item_finish(const MoeItem& m, const float (&rv)[32], LAS float* scr, int lane) {
#pragma unroll
    for (int i = 0; i < 32; ++i) scr[(2 * i + (lane >> 5)) * 33 + (lane & 31)] = rv[i];
    LDS_WAIT(); asm volatile("" ::: "memory");
    const int n = lane >> 1, kh = (lane & 1) * 32; const LAS float* s = scr + kh * 33 + n;
#pragma unroll
    for (int q = 0; q < 2; ++q) { v4u o;
#pragma unroll
        for (int d = 0; d < 4; ++d) { const LAS float* p = s + (q * 16 + d * 4) * 33; o[d] = pk4_fp8(p[0] * W8SCALE, p[33] * W8SCALE, p[66] * W8SCALE, p[99] * W8SCALE); }
        *(v4u*)(m.dst + q * 16) = o; }
    LDS_WAIT(); asm volatile("" ::: "memory");
}
__device__ __forceinline__ void p0_moe_items(Frame& F, int lo, int hi, int gw, int ngw) {
    LAS float* scr = (LAS float*)(F.lds + F.wave * 16384); const int lane = F.lane;
    int it = lo + gw; if (it >= hi) return;
    MoeItem c = moe_item_ref(F, it, lane); float rv[32]; moe_item_load(c, rv);
    for (;;) {
        const int nx = it + ngw; const bool has = nx < hi;
        const MoeItem nm = moe_item_ref(F, has ? nx : it, lane); float rn[32];
        moe_item_load(nm, rn);
        moe_item_finish(c, rv, scr, lane);
        if (!has) break;
        c = nm; it = nx;
#pragma unroll
        for (int i = 0; i < 32; ++i) rv[i] = rn[i];
    }
}
__device__ __forceinline__ void p0_prologue(Frame& F) {
    LAS float* scr = (LAS float*)(F.lds + F.wave * 16384);
    const int gw = F.vcu * NWAVES + F.wave, NGW = F.G * NWAVES, lane = F.lane;
    bf16* Win_t = (bf16*)(F.ws + WS_WIN); bf16* Wout_t = (bf16*)(F.ws + WS_WOUT);
    constexpr int I_IN = (D / 64) * (NIN / 32), I_OUT = (512 / 64) * (D / 32);
    for (int it = gw; it < I_IN + I_OUT; it += NGW) {
        int r = it;
        if (r < I_IN) { const int nb = NIN / 32; p0_transpose_item(F.w_in, NIN, Win_t, D, 64 * (r / nb), 32 * (r % nb), RmIn{}, scr, lane); continue; } r -= I_IN;
        { const int nb = D / 32; p0_transpose_item(F.w_out, D, Wout_t, D, 64 * (r / nb), 32 * (r % nb), RmId{}, scr, lane); }
    }
    p0_moe_items(F, 0, MOE_P0, gw, NGW);
    for (int it = gw; it < 512 * (D / 64); it += NGW) {
        const int kq = it / (D / 64), n = (it % (D / 64)) * 64 + lane, g = kq >> 7;
        const float* pw = F.poolw + (size_t)kq * 128; const float* ps = F.pools + g * 128; const float* wo = F.w_out + (size_t)(512 + g * 128) * D + n;
        float a = 0.f;
#pragma unroll 32
        for (int j = 0; j < 128; ++j) a += pw[j] * ps[j] * wo[(size_t)j * D];
        Wout_t[(size_t)n * D + 512 + kq] = (bf16)(pk2(a, 0.f) & 0xffffu);
    }
    bf16* XN = (bf16*)(F.ws + WS_XN);
    auto rowsrc = [&](int r) -> const f32x4* { const int b = r / L, t = r - b * L; return (const f32x4*)(t < NMETA ? F.meta + (size_t)t * D : F.x + ((size_t)b * SEQ + (t - NMETA)) * D); };
    if (gw < M) {
        f32x4 v[4], u[4], gg4[4];
#pragma unroll
        for (int j = 0; j < 4; ++j) gg4[j] = ((const f32x4*)F.ln1g)[lane + 64 * j];
        { const f32x4* s0 = rowsrc(gw); const f32x4* s1 = rowsrc(gw + NGW < M ? gw + NGW : gw);
#pragma unroll
          for (int j = 0; j < 4; ++j) { v[j] = __builtin_nontemporal_load(s0 + lane + 64 * j); u[j] = __builtin_nontemporal_load(s1 + lane + 64 * j); } }
        for (int r = gw; r < M; r += 2 * NGW) {
            const int r1 = r + NGW; const bool has1 = r1 < M; const int r1c = has1 ? r1 : r;
            const int n0 = r + 2 * NGW < M ? r + 2 * NGW : r, n1 = r + 3 * NGW < M ? r + 3 * NGW : n0;
            const f32x4* q0 = rowsrc(n0); const f32x4* q1 = rowsrc(n1);
            f32x4 vn[4], un[4];
#pragma unroll
            for (int j = 0; j < 4; ++j) { vn[j] = __builtin_nontemporal_load(q0 + lane + 64 * j); un[j] = __builtin_nontemporal_load(q1 + lane + 64 * j); }
            float ss = 0.f, su = 0.f;
#pragma unroll
            for (int j = 0; j < 4; ++j) { ss += (v[j][0] * v[j][0] + v[j][1] * v[j][1]) + (v[j][2] * v[j][2] + v[j][3] * v[j][3]); su += (u[j][0] * u[j][0] + u[j][1] * u[j][1]) + (u[j][2] * u[j][2] + u[j][3] * u[j][3]); }
            const float ms0 = wave_sum(ss) * (1.0f / D) + EPS, ms1 = wave_sum(su) * (1.0f / D) + EPS;
            const float rs0 = rsqrtf(ms0), rs1 = rsqrtf(ms1);
            if (lane == 0) { float* RINV = (float*)(F.ws + WS_RINV); RINV[r] = sqrtf(ms0); if (has1) RINV[r1c] = sqrtf(ms1); }
            unsigned long long* o0 = (unsigned long long*)(XN + (size_t)r * D) + lane; unsigned long long* o1 = (unsigned long long*)(XN + (size_t)r1c * D) + lane;
#pragma unroll
            for (int j = 0; j < 4; ++j) { const f32x4 gg = gg4[j]; const f32x4 y = v[j] * rs0 * gg, z = u[j] * rs1 * gg;
                o0[64 * j] = (unsigned long long)pk2(y[0], y[1]) | ((unsigned long long)pk2(y[2], y[3]) << 32);
                if (has1) o1[64 * j] = (unsigned long long)pk2(z[0], z[1]) | ((unsigned long long)pk2(z[2], z[3]) << 32); }
#pragma unroll
            for (int j = 0; j < 4; ++j) { v[j] = vn[j]; u[j] = un[j]; }
        }
    }
    f32x2* tab = (f32x2*)(F.ws + WS_TAB);
    for (int i = gw * 64 + lane; i < L * 32; i += NGW * 64) {
        const int t = i >> 5, k = i & 31; const float fr = exp2f(-(float)k * (13.287712379549449f / 32.0f));
        float s, c; sincosf((float)t * fr, &s, &c); float* tf = (float*)tab + (size_t)t * 64 + (k >> 1) * 4 + (k & 1); tf[0] = c; tf[2] = s;
    }
    bf16* Kb = (bf16*)(F.ws + WS_K); bf16* Vb = (bf16*)(F.ws + WS_V);
    for (int i = gw * 64 + lane; i < BATCH * (LP - L) * (AW / 8); i += NGW * 64) {
        const int ch = i % (AW / 8), rr = i / (AW / 8), b = rr / (LP - L), t = L + rr % (LP - L); const size_t o = ((size_t)b * LP + t) * AW + ch * 8;
        *(v4u*)(Kb + o) = (v4u){0u, 0u, 0u, 0u}; *(v4u*)(Vb + o) = (v4u){0u, 0u, 0u, 0u};
    }
}

__device__ __forceinline__ void p5_rows(Frame& F) {
    const int gw = F.vcu * NWAVES + F.wave, NGW = F.G * NWAVES, lane = F.lane, tid = F.tid;
    constexpr int WROW = 2064;
    LAS unsigned char* whi = F.lds; LAS unsigned char* wlo = F.lds + 16 * WROW; LAS float* g2s = (LAS float*)(F.lds + 32 * WROW);
    { f32x4 wv[8]; float gv[8];
#pragma unroll
      for (int q = 0; q < 8; ++q) { const int k = (tid >> 2) + 128 * q; wv[q] = *(const f32x4*)(F.w_router + (size_t)k * NE + 4 * (tid & 3)); gv[q] = F.ln2g[k]; }
#pragma unroll
      for (int q = 0; q < 8; ++q) { const int k = (tid >> 2) + 128 * q;
#pragma unroll
          for (int j = 0; j < 4; ++j) { const int e = 4 * (tid & 3) + j; const float w = wv[q][j] * gv[q];
              const unsigned hb = pk2(w, 0.f) & 0xffffu; const float rem = w - __uint_as_float(hb << 16);
              *(LAS bf16*)(whi + e * WROW + k * 2) = (bf16)hb; *(LAS bf16*)(wlo + e * WROW + k * 2) = (bf16)(pk2(rem, 0.f) & 0xffffu); }
          if ((tid & 3) == 0) g2s[k] = gv[q]; } }
    __syncthreads();
    unsigned char* XN8 = F.ws + WS_XN; float* AFF = (float*)(F.ws + WS_AFF); const bf16* H2 = (const bf16*)(F.ws + WS_H2);
    const int ri = lane & 15, g = lane >> 4;
    const bool spread = (F.G == 256);
    const int nfull = (M / 16) / NGW;
    for (int it = 0;; ++it) {
        int grp;
        if (!spread || it < nfull) { grp = gw + it * NGW; if (grp >= M / 16) break; }
        else { const int j = F.vcu >> 3; if (it > nfull || F.wave != 0 || (F.vcu & 7) != (j & 7) || nfull * NGW + j >= M / 16) break; grp = nfull * NGW + j; }
        const int row = grp * 16 + ri;
        const v4u* src = (const v4u*)(H2 + (size_t)row * D + 8 * g);
        v4u x[32];
#pragma unroll
        for (int s = 0; s < 32; ++s) x[s] = src[4 * s];
        f32x4 acc = (f32x4){0.f, 0.f, 0.f, 0.f}; float ss = 0.f;
#pragma unroll
        for (int s = 0; s < 32; ++s) {
            const bf16x8 bh = *(const LAS bf16x8*)(whi + ri * WROW + (32 * s + 8 * g) * 2), bl = *(const LAS bf16x8*)(wlo + ri * WROW + (32 * s + 8 * g) * 2);
            const bf16x8 af = __builtin_bit_cast(bf16x8, x[s]);
            acc = __builtin_amdgcn_mfma_f32_16x16x32_bf16(af, bh, acc, 0, 0, 0);
            acc = __builtin_amdgcn_mfma_f32_16x16x32_bf16(af, bl, acc, 0, 0, 0);
#pragma unroll
            for (int q = 0; q < 4; ++q) { const float lo = bf_lo(x[s][q]), hi = bf_hi(x[s][q]); ss += lo * lo + hi * hi; }
            if (s & 1) __builtin_amdgcn_sched_barrier(0);
        }
        ss = swap32_sum(swap16_sum(ss));
        const float rstd = rsqrtf(ss * (1.0f / D) + EPS);
        unsigned char* dst = XN8 + (size_t)row * D + 8 * g;
#pragma unroll
        for (int s = 0; s < 32; ++s) { const f32x4 ga = *(const LAS f32x4*)(g2s + 32 * s + 8 * g), gb = *(const LAS f32x4*)(g2s + 32 * s + 8 * g + 4);
            asm volatile("" : "+v"(x[s]));
            pg8::u32x2 w;
            const f32x2 y0 = ((f32x2){bf_lo(x[s][0]), bf_hi(x[s][0])} * __builtin_shufflevector(ga, ga, 0, 1)) * rstd, y1 = ((f32x2){bf_lo(x[s][1]), bf_hi(x[s][1])} * __builtin_shufflevector(ga, ga, 2, 3)) * rstd;
            const f32x2 y2 = ((f32x2){bf_lo(x[s][2]), bf_hi(x[s][2])} * __builtin_shufflevector(gb, gb, 0, 1)) * rstd, y3 = ((f32x2){bf_lo(x[s][3]), bf_hi(x[s][3])} * __builtin_shufflevector(gb, gb, 2, 3)) * rstd;
            w.x = pk4_fp8(y0.x, y0.y, y1.x, y1.y); w.y = pk4_fp8(y2.x, y2.y, y3.x, y3.y);
            *(pg8::u32x2*)(dst + 32 * s) = w;
            if (s & 1) __builtin_amdgcn_sched_barrier(0); }
#pragma unroll
        for (int r = 0; r < 4; ++r) { const float lg = acc[r] * __shfl(rstd, 4 * g + r);
            const float mx = row16_max(lg);
            const float ex = __expf(lg - mx); const float sm = row16_sum(ex);
            AFF[(size_t)(grp * 16 + 4 * g + r) * NE + ri] = ex / sm; }
    }
    __syncthreads();
}

__device__ __forceinline__ void p6_select(Frame& F) {
    LAS unsigned* key = (LAS unsigned*)F.lds;
    LAS unsigned* const key2 = key;
    LAS unsigned* hist = key + 2 * 2080;
    LAS unsigned* sel = hist + 768;
    LAS unsigned* wtot = sel + 8;
    const float* AFF = (const float*)(F.ws + WS_AFF); int* SLOT = (int*)(F.ws + WS_SLOT); int* ROWIDX = (int*)(F.ws + WS_ROWIDX); float* ROWGATE = (float*)(F.ws + WS_ROWGATE);
    const int tid = F.tid, lane = F.lane, wid = F.wave;
    for (int pr = F.vcu; pr < BATCH * NE / 2; pr += F.G) {
      const int b = pr >> 3, e0 = pr & 7;
      { float kv[5], kw[5];
#pragma unroll
        for (int q = 0; q < 5; ++q) { const int t = tid + q * NWAVES * 64; const float* ap = AFF + ((size_t)b * L + (t < L ? t : L - 1)) * NE + e0; kv[q] = ap[0]; kw[q] = ap[8]; }
#pragma unroll
        for (int q = 0; q < 5; ++q) { const int t = tid + q * NWAVES * 64; if (t < L) { key2[t] = __float_as_uint(kv[q]); key2[2080 + t] = __float_as_uint(kw[q]); } } }
      for (int z = 0; z < 2; ++z) {
        const int e = e0 + 8 * z; LAS unsigned* key = key2 + z * 2080;
        unsigned prefix = 0u, maskbits = 0u, need = CAP;
        if (tid < 256) hist[tid] = 0u;
        __syncthreads();
        int hb = 0;
#pragma unroll 1
        for (int pass = 0; pass < 4; ++pass) { const int shift = pass < 3 ? 22 - 8 * pass : 0;
            LAS unsigned* hc = hist + hb * 256; const int hn = hb == 2 ? 0 : hb + 1;
            if (tid < 256) hist[hn * 256 + tid] = 0u;
            for (int t = tid; t < L; t += NWAVES * 64) { const unsigned k = key[t]; if ((k & maskbits) == prefix) atomicAdd((unsigned*)&hc[(k >> shift) & 255u], 1u); }
            __syncthreads();
            unsigned c[4], s4 = 0u;
#pragma unroll
            for (int q = 0; q < 4; ++q) { c[q] = hc[255 - (4 * lane + q)]; s4 += c[q]; }
            const unsigned incl = wave_scan_incl(s4, lane);
            const unsigned excl = incl - s4;
            const bool mine = excl < need && need <= incl;
            unsigned dgl = 0u, nnl = 0u;
            if (mine) { unsigned cum = excl; bool found = false;
#pragma unroll
                for (int q = 0; q < 4; ++q) { if (!found && cum + c[q] >= need) { dgl = 255u - (unsigned)(4 * lane + q); nnl = need - cum; found = true; } if (!found) cum += c[q]; } }
            const int src = __builtin_ctzll(__ballot(mine));
            const unsigned dg = (unsigned)__builtin_amdgcn_readlane((int)dgl, src); need = (unsigned)__builtin_amdgcn_readlane((int)nnl, src);
            prefix |= dg << shift; maskbits |= 255u << shift;
            hb = hn;
        }
        const int t0 = tid * 5;
        unsigned cg = 0u, ce = 0u;
#pragma unroll
        for (int i = 0; i < 5; ++i) { const int t = t0 + i; if (t < L) { const unsigned k = key[t]; cg += (k > prefix) ? 1u : 0u; ce += (k == prefix) ? 1u : 0u; } }
        const unsigned pk = cg | (ce << 16); const unsigned incl = wave_scan_incl(pk, lane);
        if (lane == 63) wtot[wid] = incl;
        __syncthreads();
        unsigned base = 0u;
        for (int w = 0; w < wid; ++w) base += wtot[w];
        unsigned excl = base + incl - pk;
        unsigned gb = excl & 0xffffu, eb = excl >> 16;
#pragma unroll
        for (int i = 0; i < 5; ++i) { const int t = t0 + i; if (t < L) { const unsigned k = key[t]; const bool isg = k > prefix, ise = k == prefix;
            const bool s = isg || (ise && eb < need); const unsigned slot = gb + (eb < need ? eb : need);
            SLOT[((size_t)b * L + t) * NE + e] = s ? (int)slot : -1;
            if (s) { ROWIDX[(size_t)e * EP + b * CAP + slot] = b * L + t; ROWGATE[(size_t)e * EP + b * CAP + slot] = __uint_as_float(k); }
            gb += isg ? 1u : 0u; eb += ise ? 1u : 0u; } }
        if (b == 0) for (int i = tid; i < EP - ER; i += NWAVES * 64) { ROWIDX[(size_t)e * EP + ER + i] = 0; ROWGATE[(size_t)e * EP + ER + i] = 0.f; }
        __syncthreads();
      }
    }
}

__device__ __forceinline__ void p9_combine(Frame& F) {
    const int gw = F.vcu * NWAVES + F.wave, NGW = F.G * NWAVES, lane = F.lane;
    const int* SLOT = (const int*)(F.ws + WS_SLOT); const unsigned char* Y = F.ws + WS_Y; const bf16* H2 = (const bf16*)(F.ws + WS_H2);
    typedef unsigned u32x2v __attribute__((ext_vector_type(2)));
#define ACC8(A0, A1, W) do { A0[0] += bf_lo(W[0]); A0[1] += bf_hi(W[0]); A0[2] += bf_lo(W[1]); A0[3] += bf_hi(W[1]); A1[0] += bf_lo(W[2]); A1[1] += bf_hi(W[2]); A1[2] += bf_lo(W[3]); A1[3] += bf_hi(W[3]); } while (0)
#define ACCF8(A0, A1, W) do { const f32x2 c0_ = __builtin_amdgcn_cvt_pk_f32_fp8((int)W[0], false), c1_ = __builtin_amdgcn_cvt_pk_f32_fp8((int)W[0], true), \
        c2_ = __builtin_amdgcn_cvt_pk_f32_fp8((int)W[1], false), c3_ = __builtin_amdgcn_cvt_pk_f32_fp8((int)W[1], true); \
        A0[0] += c0_[0]; A0[1] += c0_[1]; A0[2] += c1_[0]; A0[3] += c1_[1]; A1[0] += c2_[0]; A1[1] += c2_[1]; A1[2] += c3_[0]; A1[3] += c3_[1]; } while (0)
    v4u h0 = (v4u){0u, 0u, 0u, 0u}, h1 = h0; int sl = -1;
    if (gw < BATCH * SEQ) { const int b = gw / SEQ, t = NMETA + (gw - b * SEQ); const bf16* hr = H2 + ((size_t)b * L + t) * D;
        h0 = __builtin_nontemporal_load((const v4u*)(hr + 8 * lane)); h1 = __builtin_nontemporal_load((const v4u*)(hr + 512 + 8 * lane)); sl = lane < NE ? SLOT[((size_t)b * L + t) * NE + lane] : -1; }
    for (int r = gw; r < BATCH * SEQ; r += NGW) {
        const int b = r / SEQ;
        float* orow = F.out + (size_t)r * D;
        f32x4 a[4], ym[4];
#pragma unroll
        for (int j = 0; j < 4; ++j) { a[j] = (f32x4){0.f, 0.f, 0.f, 0.f}; ym[j] = a[j]; }
        ACC8(a[0], a[1], h0); ACC8(a[2], a[3], h1);
        unsigned long long mk = __ballot(sl >= 0);
        u32x2v y0[4], y1[4];
#pragma unroll
        for (int q = 0; q < 4; ++q) { y0[q] = (u32x2v){0u, 0u}; y1[q] = y0[q];
            if (mk) { const int e = __builtin_ctzll(mk); mk &= mk - 1; const int s = __builtin_amdgcn_readlane(sl, e); const unsigned char* yr = Y + ((size_t)e * EP + b * CAP + s) * D;
                y0[q] = __builtin_nontemporal_load((const u32x2v*)(yr + 8 * lane)); y1[q] = __builtin_nontemporal_load((const u32x2v*)(yr + 512 + 8 * lane)); } }
        const int slc = sl;
        const int rn = r + NGW;
        if (rn < BATCH * SEQ) { const int bn = rn / SEQ, tn = NMETA + (rn - bn * SEQ); const bf16* hr = H2 + ((size_t)bn * L + tn) * D;
            h0 = __builtin_nontemporal_load((const v4u*)(hr + 8 * lane)); h1 = __builtin_nontemporal_load((const v4u*)(hr + 512 + 8 * lane)); sl = lane < NE ? SLOT[((size_t)bn * L + tn) * NE + lane] : -1; }
#pragma unroll
        for (int q = 0; q < 4; ++q) { ACCF8(ym[0], ym[1], y0[q]); ACCF8(ym[2], ym[3], y1[q]); }
        while (mk) { const int e = __builtin_ctzll(mk); mk &= mk - 1; const int s = __builtin_amdgcn_readlane(slc, e);
            const unsigned char* yr = Y + ((size_t)e * EP + b * CAP + s) * D;
            const u32x2v z0 = *(const u32x2v*)(yr + 8 * lane), z1 = *(const u32x2v*)(yr + 512 + 8 * lane);
            ACCF8(ym[0], ym[1], z0); ACCF8(ym[2], ym[3], z1); }
#pragma unroll
        for (int j = 0; j < 4; ++j) ((f32x4*)orow)[2 * lane + (j & 1) + 128 * (j >> 1)] = a[j] + ym[j] * (1.0f / 16.0f);
    }
#undef ACC8
#undef ACCF8
}

struct Args { const float* in[19]; float* out; unsigned char* ws; int ph_lo, ph_hi; };
__global__ void __launch_bounds__(NWAVES * 64, 2) mk_fwd(Args args) {
    extern __shared__ __attribute__((aligned(16))) unsigned char lds[];
    Frame F;
    F.lds = (LAS unsigned char*)lds;
    F.MISC = (volatile LAS unsigned*)(F.lds + MISC_OFF);
    F.tid = threadIdx.x; F.lane = F.tid & 63; F.wave = __builtin_amdgcn_readfirstlane(F.tid >> 6);
    F.G = gridDim.x; { const int bx = blockIdx.x; F.vcu = (F.G % 8 == 0) ? (bx % 8) * (F.G / 8) + bx / 8 : bx; }
    F.x = args.in[0]; F.meta = args.in[1]; F.ln1g = args.in[2]; F.w_in = args.in[3]; F.qng = args.in[4]; F.kng = args.in[5]; F.lq1 = args.in[6]; F.lk1 = args.in[7];
    F.lq2 = args.in[8]; F.lk2 = args.in[9]; F.subg = args.in[10]; F.poolw = args.in[11]; F.pools = args.in[12]; F.w_out = args.in[13]; F.ln2g = args.in[14];
    F.w_router = args.in[15]; F.w_gate = args.in[16]; F.w_up = args.in[17]; F.w_down = args.in[18]; F.out = args.out; F.ws = args.ws;
    unsigned char* ws = args.ws;
    for (int u = F.tid; u < (LDS_BYTES - LDSCTL_OFF) / 4; u += NWAVES * 64) ((LAS unsigned*)(F.lds + LDSCTL_OFF))[u] = 0u;
    __syncthreads();
    XcdBarrier bar; bar.bar = (unsigned*)(ws + WS_CTL) + CW_BAR; bar.x = 0; bar.st = nullptr;
    if (MK_N_LAUNCHES == 1) bar = xcd_barrier_post((unsigned*)(ws + WS_CTL) + CW_BAR, F.MISC + 8);
    const int lo = args.ph_lo, hi = args.ph_hi;
#ifndef PH_MASK
#define PH_MASK 0x3ff
#endif
#define IN(k) (((PH_MASK >> (k)) & 1) && lo <= (k) && (k) < hi)
#define SEAM(k) do { if (IN(k) && IN((k) + 1)) xcd_barrier(bar); } while (0)
#ifndef PROBE_REP
#define PROBE_REP 0
#endif
#define REP(k) for (int _r = 0; _r <= ((PROBE_REP >> (k)) & 1); ++_r, (_r <= ((PROBE_REP >> (k)) & 1)) ? xcd_barrier(bar) : (void)0)

    if (IN(0)) REP(0) { p0_prologue(F); } SEAM(0);

    if (IN(1)) REP(1) {
        pg8::Gemm g{(const bf16*)(ws + WS_XN), (const bf16*)(ws + WS_WIN), D, nullptr}; pg8::StaticOrder S; S.init(M / 256, NIN / 256, F.G, (int)blockIdx.x, 0);
        pg8::EpiProj E{(bf16*)(ws + WS_Q), (bf16*)(ws + WS_K), (bf16*)(ws + WS_V), (bf16*)(ws + WS_P), (const f32x2*)(ws + WS_TAB), F.qng, F.kng};
        pg8::gemm_phase<pg8::EpiProj, false>(F.lds, g, S, E);
        { const int nx = (M / 256) * (NIN / 256) % F.G;
          if ((int)blockIdx.x >= nx) p0_moe_items(F, MOE_P0, MOE_F1, ((int)blockIdx.x - nx) * NWAVES + F.wave, (F.G - nx) * NWAVES); }
    } SEAM(1);

    if (IN(2)) REP(2) {
        const bf16* Q = (const bf16*)(ws + WS_Q); const bf16* Kb = (const bf16*)(ws + WS_K); const bf16* Vb = (const bf16*)(ws + WS_V); const bf16* Pp = (const bf16*)(ws + WS_P);
        bf16* MIX = (bf16*)(ws + WS_MIX); bf16* OAR = (bf16*)(ws + WS_OA);
        unsigned* pcnt = (unsigned*)(ws + WS_CTL) + CW_PAIR;
        const int lane = F.lane, wid = F.wave;
        const float lam = __expf(wave_sum(F.lq1[lane] * F.lk1[lane])) - __expf(wave_sum(F.lq2[lane] * F.lk2[lane])) + LAM_INIT;
        for (int s = F.vcu; s < BATCH * NH * 2; s += F.G) {
            const int p = s >> 1, c = s & 1, b = p >> 2, h = p & 3;
            const bf16* Kh = Kb + (size_t)b * LP * AW + 2 * h * DH; const bf16* Vh = Vb + (size_t)b * LP * AW + h * DV;
            for (int u = 0; u < 4; ++u) {
                const int q0 = (4 * c + u) * 256;
                const att::MixArgs ma{MIX, Pp, F.subg, lam, b, h, q0};
                att::attn_unit<1>(Q + ((size_t)b * L + q0) * AW + 2 * h * DH, Kh, Vh, nullptr, 0, 256, ma, (LAS char*)F.lds, u > 0, u < 3);
            }
            {
                const att::MixArgs ma0{MIX, Pp, F.subg, lam, b, h, 8 * 256};
                att::attn_rem_unit(Q + ((size_t)b * L + 2048) * AW + (2 * h + c) * DH, Kh + c * DH, Vh, OAR + (size_t)(p * 2 + c) * 16 * DV, L - 2048, (LAS char*)F.lds);
                int lane_r = threadIdx.x & 63; asm volatile("" : "+v"(lane_r));
                const int row = 2 * wid + (lane_r >> 5), t = 2048 + row, cq = (lane_r & 31) * 4;
                if (c == 0) {
                    const int w2 = 1 << h; const bf16* Pb = Pp + (size_t)b * L * AW + h * 128 + cq;
                    const int lo = t - w2, hi2 = (t + w2) < L ? (t + w2) : L;
                    float acc[4] = {0.f, 0.f, 0.f, 0.f};
                    for (int k = -w2; k < w2; ++k) { const int tt = t + k; const bool in = tt < hi2; const f32x2 pv = *(const f32x2*)(Pb + (size_t)(in ? tt : t) * AW); const float mk = in ? 1.0f : 0.0f;
                        const unsigned w0 = __float_as_uint(pv[0]), w1 = __float_as_uint(pv[1]);
                        acc[0] += mk * bf_lo(w0); acc[1] += mk * bf_hi(w0); acc[2] += mk * bf_lo(w1); acc[3] += mk * bf_hi(w1); }
                    const float inv = 1.0f / (float)(hi2 - lo);
                    const f32x2 pc = *(const f32x2*)(Pb + (size_t)t * AW); const unsigned c0 = __float_as_uint(pc[0]), c1 = __float_as_uint(pc[1]);
                    pg8::u32x2 wp; wp.x = pk2(acc[0] * inv - bf_lo(c0), acc[1] * inv - bf_hi(c0)); wp.y = pk2(acc[2] * inv - bf_lo(c1), acc[3] * inv - bf_hi(c1));
                    *(pg8::u32x2*)(MIX + ((size_t)b * L + t) * D + 512 + h * 128 + cq) = wp;
                }
                __syncthreads();
                if (F.tid == 0) { __builtin_amdgcn_fence(__ATOMIC_RELEASE, "agent"); asm volatile("s_waitcnt vmcnt(0)" ::: "memory");
                    const unsigned old = __hip_atomic_fetch_add(pcnt + p, 1u, __ATOMIC_RELAXED, __HIP_MEMORY_SCOPE_AGENT);
                    if (old == 1u) { __builtin_amdgcn_fence(__ATOMIC_ACQUIRE, "agent"); asm volatile("s_waitcnt vmcnt(0)" ::: "memory"); }
                    F.MISC[16] = old; }
                __syncthreads();
                if (F.MISC[16] == 1u) {
                    const bf16* o0 = OAR + (size_t)(p * 2) * 16 * DV + row * DV + cq; const bf16* o1 = o0 + 16 * DV;
                    const f32x2 a0 = *(const f32x2*)o0, a1 = *(const f32x2*)o1;
                    const unsigned x0 = __float_as_uint(a0[0]), x1 = __float_as_uint(a0[1]), y0 = __float_as_uint(a1[0]), y1 = __float_as_uint(a1[1]);
                    float d[4] = {bf_lo(x0) - lam * bf_lo(y0), bf_hi(x0) - lam * bf_hi(y0), bf_lo(x1) - lam * bf_lo(y1), bf_hi(x1) - lam * bf_hi(y1)};
                    float ss = (d[0] * d[0] + d[1] * d[1]) + (d[2] * d[2] + d[3] * d[3]);
                    ss = swap16_sum(row16_sum(ss));
                    const float rstd = rsqrtf(ss * (1.0f / DV) + EPS) * (1.0f - LAM_INIT);
                    pg8::u32x2 w; w.x = pk2(d[0] * rstd * F.subg[cq], d[1] * rstd * F.subg[cq + 1]); w.y = pk2(d[2] * rstd * F.subg[cq + 2], d[3] * rstd * F.subg[cq + 3]);
                    *(pg8::u32x2*)(MIX + ((size_t)b * L + t) * D + h * DV + cq) = w;
                }
                __syncthreads();
            }
        }
    } SEAM(2);

    if (IN(4)) REP(4) {
        pg8::Gemm g{(const bf16*)(ws + WS_MIX), (const bf16*)(ws + WS_WOUT), D, nullptr}; pg8::StaticOrder S; S.init(M / 256, D / 256, F.G, (int)blockIdx.x, 0);
        pg8::EpiOut E{(const bf16*)(ws + WS_XN), (const float*)(ws + WS_RINV), F.ln1g, (bf16*)(ws + WS_H2)};
        pg8::gemm_phase<pg8::EpiOut, false>(F.lds, g, S, E);
        { const int nx = (M / 256) * (D / 256) % F.G;
          if ((int)blockIdx.x >= nx) p0_moe_items(F, MOE_F1, MOE_ITEMS, ((int)blockIdx.x - nx) * NWAVES + F.wave, (F.G - nx) * NWAVES); }
    } SEAM(4);

    if (IN(5)) REP(5) { p5_rows(F); } SEAM(5);
    if (IN(6)) REP(6) { p6_select(F); } SEAM(6);

    if (IN(7)) REP(7) {
        pg8::Gemm g{(const bf16*)(ws + WS_XN), (const bf16*)(ws + WS_WGU), D / 2, (const int*)(ws + WS_ROWIDX)}; pg8::StaticOrder S; S.init(MT / 256, 2 * FF / 256, F.G, (int)blockIdx.x, EP / 256);
        pg8::EpiGU E{ws + WS_A2};
        pg8::gemm_phase<pg8::EpiGU, true, 1>(F.lds, g, S, E);
    } SEAM(7);

    if (IN(8)) REP(8) {
        pg8::Gemm g{(const bf16*)(ws + WS_A2), (const bf16*)(ws + WS_WD), FF / 2, nullptr}; pg8::StaticOrder S; S.init(MT / 256, D / 256, F.G, (int)blockIdx.x, EP / 256);
        pg8::EpiDown E{ws + WS_Y, (const float*)(ws + WS_ROWGATE)};
        pg8::gemm_phase<pg8::EpiDown, false, 1, false, true>(F.lds, g, S, E);
    } SEAM(8);

    if (IN(9)) { p9_combine(F); }
#undef IN
#undef SEAM
}

extern "C" void kernel_launch(void* const* d_in, const int* in_sizes, int n_in, void* d_out, int out_size, void* d_ws, size_t ws_size, hipStream_t stream) {
    static int grid = 0;
    if (grid == 0) {
        if (n_in != 19 || in_sizes[0] != BATCH * SEQ * D || out_size != BATCH * SEQ * D || ws_size < WS_END) {
            fprintf(stderr, "kernel_launch: unexpected shapes (n_in %d, in0 %d, out %d, ws %zu < %zu)\n", n_in, n_in > 0 ? in_sizes[0] : -1, out_size, ws_size, (size_t)WS_END); grid = -1; return; }
        int dev = 0, cus = 0;
        if (hipGetDevice(&dev) != hipSuccess || hipDeviceGetAttribute(&cus, hipDeviceAttributeMultiprocessorCount, dev) != hipSuccess) { grid = -1; return; }
        if (hipFuncSetAttribute((const void*)mk_fwd, hipFuncAttributeMaxDynamicSharedMemorySize, LDS_BYTES) != hipSuccess) { fprintf(stderr, "kernel_launch: hipFuncSetAttribute failed\n"); grid = -1; return; }
        (void)hipGetLastError();
        grid = cus;
    }
    if (grid < 0) return;
    if (hipMemsetAsync((char*)d_ws + WS_CTL, 0, CTL_ZERO_BYTES, stream) != hipSuccess) { fprintf(stderr, "kernel_launch: memset failed\n"); return; }
    Args a{};
    for (int i = 0; i < 19; ++i) a.in[i] = (const float*)d_in[i];
    a.out = (float*)d_out; a.ws = (unsigned char*)d_ws;
#if defined(PROBE_LO)
    { const int seg[3][2] = {{0, 9}, {PROBE_LO, PROBE_HI}, {9, 10}};
      for (int li = 0; li < 3; ++li) { a.ph_lo = seg[li][0]; a.ph_hi = seg[li][1]; hipLaunchKernelGGL(mk_fwd, dim3(grid), dim3(NWAVES * 64), LDS_BYTES, stream, a); }
      return; }
#endif
    for (int li = 0; li < MK_N_LAUNCHES; ++li) {
        a.ph_lo = (MK_N_LAUNCHES == 1) ? 0 : li; a.ph_hi = (MK_N_LAUNCHES == 1) ? NPHASE : li + 1;
        hipLaunchKernelGGL(mk_fwd, dim3(grid), dim3(NWAVES * 64), LDS_BYTES, stream, a);
        const hipError_t le = hipPeekAtLastError();
        if (le != hipSuccess) { fprintf(stderr, "kernel_launch: launch %d failed: %s\n", li, hipGetErrorName(le)); break; }
    }
}
```
